# Optimizing an MI355X kernel written in HIP

```python
import math
import jax, jax.numpy as jnp
from jax import lax
import numpy as np

D_MODEL = 1024
BATCH = 16
SEQ = 256
DEPTH = 2
DEC_BATCH = 4
DEC_SEQ = 4096
PAST_LEN = 256

GRID_W = 64
ROPE_BASE = 10000.0
EPS = 1e-6
Q_BLOCK = 128
H_A = 4
DK_A = 64
DV_A = 128
GATE_RANK = 16
GATE_TAU = 16.0
CHUNK = 64
W_A = H_A * DV_A
H_B = 8
Q_RANK = 384
KV_RANK = 256
NOPE_B = 64
ROPE_B = 32
V_B = 64
QK_B = NOPE_B + ROPE_B
W_B = H_B * V_B
H_C = 4
D_C = 64
W_C = H_C * 2 * D_C
D_FF = 4 * D_MODEL
N_BRANCH = 3
IN_WIDTHS = (H_A * DK_A, H_A * DK_A, W_A, W_A, 2 * GATE_RANK, Q_RANK, KV_RANK, ROPE_B, H_C * 2 * D_C, H_C * 2 * D_C, W_C, N_BRANCH * D_MODEL)
IN_COLS = sum(IN_WIDTHS)

kernel_name = 'hybrid_gla_mla_diff_prefix_dit_step'


def rms_norm(x, g):
    xf = x.astype(jnp.float32)
    y = xf * lax.rsqrt(jnp.mean(xf * xf, axis=-1, keepdims=True) + EPS)
    return y.astype(x.dtype) * g


def grid_positions(n):
    rows = n // GRID_W
    t = jnp.arange(rows * GRID_W)
    return t // GRID_W, t % GRID_W


def _rotate(xh, pos):
    nf = xh.shape[-1] // 2
    inv = ROPE_BASE ** (-jnp.arange(nf, dtype=jnp.float32) / nf)
    ang = pos.astype(jnp.float32)[:, None] * inv[None, :]
    ang = ang.reshape((1, ang.shape[0]) + (1,) * (xh.ndim - 3) + (nf,))
    cos = jnp.cos(ang).astype(xh.dtype)
    sin = jnp.sin(ang).astype(xh.dtype)
    x1, x2 = xh[..., :nf], xh[..., nf:]
    return jnp.concatenate([x1 * cos - x2 * sin, x1 * sin + x2 * cos], axis=-1)


def axial_rope(x, row, col):
    half = x.shape[-1] // 2
    return jnp.concatenate([_rotate(x[..., :half], row), _rotate(x[..., half:], col)], axis=-1)


def rope_tail(x, row, col):
    return jnp.concatenate([x[..., :NOPE_B], axial_rope(x[..., NOPE_B:], row, col)], axis=-1)


def gla_chunk_scan(q, k, v, g, s0):
    B, S, H, _ = q.shape
    dv = v.shape[-1]
    n = S // CHUNK

    def chunks(t):
        return t.reshape(B, n, CHUNK, H, t.shape[-1]).transpose(1, 0, 3, 2, 4)

    causal = jnp.tril(jnp.ones((CHUNK, CHUNK), dtype=bool))[:, :, None]

    def step(state, inp):
        qc, kc, vc, gc = inp
        b = jnp.cumsum(gc, axis=2)
        inter = jnp.einsum('bhtd,bhdv->bhtv', qc * jnp.exp(b), state)
        rel = jnp.where(causal, b[:, :, :, None, :] - b[:, :, None, :, :], -jnp.inf)
        att = jnp.einsum('bhtd,bhsd,bhtsd->bhts', qc, kc, jnp.exp(rel))
        intra = jnp.einsum('bhts,bhsv->bhtv', att, vc)
        b_end = b[:, :, -1:, :]
        new_state = jnp.exp(b_end[:, :, 0, :, None]) * state + jnp.einsum('bhsd,bhsv->bhdv', kc * jnp.exp(b_end - b), vc)
        return new_state, inter + intra

    final, out = lax.scan(step, s0.astype(jnp.float32), (chunks(q), chunks(k), chunks(v), chunks(g)))
    out = out.transpose(1, 0, 3, 2, 4).reshape(B, S, H, dv)
    return out, final


def gla_branch(q, k, v, r, a_lr, w_a2, b_a, g_out, s0):
    B, S, _ = q.shape
    f32 = jnp.float32
    q = q.reshape(B, S, H_A, DK_A).astype(f32) * (DK_A ** -0.5)
    k = k.reshape(B, S, H_A, DK_A).astype(f32)
    v = v.reshape(B, S, H_A, DV_A).astype(f32)
    a = a_lr.reshape(B, S, 2, GATE_RANK).astype(f32)
    logits = jnp.einsum('bsjr,jrk->bsjk', a, w_a2.astype(f32)) + b_a.astype(f32)
    g = (jax.nn.log_sigmoid(logits) / GATE_TAU).reshape(B, S, 2, H_A, DK_A)
    o_f, s_f = gla_chunk_scan(q, k, v, g[:, :, 0], s0[:, 0])
    flip = lambda t: jnp.flip(t, axis=1)
    o_b, s_b = gla_chunk_scan(flip(q), flip(k), flip(v), flip(g[:, :, 1]), s0[:, 1])
    o = rms_norm(o_f + flip(o_b), g_out.astype(f32))
    y = o.reshape(B, S, W_A).astype(r.dtype) * jax.nn.silu(r)
    return y, jnp.stack([s_f, s_b], axis=1)


def mla_queries(qd, g_qa, w_uq, g_q):
    B, S, _ = qd.shape
    q = (rms_norm(qd, g_qa) @ w_uq).reshape(B, S, H_B, QK_B)
    return rms_norm(q, g_q)


def mla_keys_values(ckv, krope, w_uk, w_uv, g_k):
    B, T, _ = ckv.shape
    k_nope = (ckv @ w_uk).reshape(B, T, H_B, NOPE_B)
    k_rope = jnp.broadcast_to(krope[:, :, None, :], (B, T, H_B, ROPE_B))
    k = rms_norm(jnp.concatenate([k_nope, k_rope], axis=-1), g_k)
    v = (ckv @ w_uv).reshape(B, T, H_B, V_B)
    return k, v


def _blocks(q):
    B, S = q.shape[:2]
    return q.reshape((B, S // Q_BLOCK, Q_BLOCK) + q.shape[2:]).swapaxes(0, 1)


def _unblocks(o):
    n, B, qb = o.shape[:3]
    return o.swapaxes(0, 1).reshape((B, n * qb) + o.shape[3:])


def softmax_attend(q, k, v):
    scale = q.shape[-1] ** -0.5

    def block(qb):
        s = jnp.einsum('bqhd,bkhd->bhqk', qb, k).astype(jnp.float32) * scale
        p = jax.nn.softmax(s, axis=-1).astype(v.dtype)
        return jnp.einsum('bhqk,bkhe->bqhe', p, v)

    return _unblocks(lax.map(block, _blocks(q)))


def diff_attend(q, k, v, lam):
    scale = q.shape[-1] ** -0.5

    def block(qb):
        s = jnp.einsum('bqhcd,bkhcd->bchqk', qb, k).astype(jnp.float32) * scale
        p = jax.nn.softmax(s, axis=-1)
        a = (p[:, 0] - lam * p[:, 1]).astype(v.dtype)
        return jnp.einsum('bhqk,bkhe->bqhe', a, v)

    return _unblocks(lax.map(block, _blocks(q)))


def layer(x, cond, lp, lam_init, cached):
    B, S, _ = x.shape
    mod = jax.nn.silu(cond) @ lp['w_mod'] + lp['b_mod']
    sh1, sc1, gt1, sh2, sc2, gt2 = jnp.split(mod, 6, axis=-1)
    h = rms_norm(x, lp['g_norm1']) * (1 + sc1) + sh1
    offsets = [int(o) for o in np.cumsum(IN_WIDTHS)[:-1]]
    (aq, ak, av, ar, aa, qd, kvd, kr, dq, dk, dv, gates) = jnp.split(h @ lp['w_in'], offsets, axis=-1)
    is_latent = cached is not None

    s0 = cached[0] if is_latent else jnp.zeros((B, 2, H_A, DK_A, DV_A), jnp.float32)
    y_a, gla_state = gla_branch(aq, ak, av, ar, aa, lp['w_gla_a2'], lp['b_gla_a'], lp['g_gla_out'], s0)

    q_b = mla_queries(qd, lp['g_mla_qa'], lp['w_mla_uq'], lp['g_mla_q'])
    ckv = rms_norm(kvd, lp['g_mla_kva'])
    k_b, v_b = mla_keys_values(ckv, kr, lp['w_mla_uk'], lp['w_mla_uv'], lp['g_mla_k'])

    q_c = rms_norm(dq.reshape(B, S, H_C, 2, D_C), lp['g_diff_q'])
    k_c = rms_norm(dk.reshape(B, S, H_C, 2, D_C), lp['g_diff_k'])
    v_c = dv.reshape(B, S, H_C, 2 * D_C)

    if is_latent:
        row, col = grid_positions(S)
        q_b = rope_tail(q_b, row, col)
        k_b = rope_tail(k_b, row, col)
        k_bc, v_bc = mla_keys_values(cached[1], cached[2], lp['w_mla_uk'], lp['w_mla_uv'], lp['g_mla_k'])
        k_b = jnp.concatenate([k_bc, k_b], axis=1)
        v_b = jnp.concatenate([v_bc, v_b], axis=1)
        q_c = axial_rope(q_c, row, col)
        k_c = jnp.concatenate([cached[3], axial_rope(k_c, row, col)], axis=1)
        v_c = jnp.concatenate([cached[4], v_c], axis=1)
        new_state = None
    else:
        new_state = (gla_state.astype(x.dtype), ckv, kr, k_c, v_c)

    y_b = softmax_attend(q_b, k_b, v_b).reshape(B, S, W_B)
    lam_p = lp['lam_qk'].astype(jnp.float32)
    lam = jnp.exp(jnp.sum(lam_p[0] * lam_p[1])) - jnp.exp(jnp.sum(lam_p[2] * lam_p[3])) + lam_init
    y_c = rms_norm(diff_attend(q_c, k_c, v_c, lam), lp['g_diff_sub']) * (1.0 - lam_init)
    y_c = y_c.reshape(B, S, W_C)

    g_a, g_b, g_c = jnp.split(jax.nn.sigmoid(gates), N_BRANCH, axis=-1)
    merged = g_a * (y_a @ lp['w_o_gla']) + g_b * (y_b @ lp['w_o_mla']) + g_c * (y_c @ lp['w_o_diff'])
    x = x + gt1 * (merged @ lp['w_out'])

    h2 = rms_norm(x, lp['g_norm2']) * (1 + sc2) + sh2
    x = x + gt2 * (jnp.square(jax.nn.relu(h2 @ lp['w_mlp1'])) @ lp['w_mlp2'])
    return x, new_state


def setup_inputs(seed: int = 0) -> dict:
    key = jax.random.key(seed)
    ks = iter(jax.random.split(key, 48))
    f32 = jnp.float32

    def nrm(shape, scale=1.0):
        return jax.random.normal(next(ks), shape, f32) * scale

    def gain(shape):
        return 1.0 + nrm(shape, 0.02)

    D = D_MODEL
    return {
        'x_prompt': nrm((BATCH, SEQ, D)),
        'x_sample': nrm((DEC_BATCH, DEC_SEQ, D)),
        'state_gla': nrm((DEC_BATCH, DEPTH, 2, H_A, DK_A, DV_A), 0.5),
        'cache_mla_ckv': nrm((DEC_BATCH, DEPTH, PAST_LEN, KV_RANK)),
        'cache_mla_krope': nrm((DEC_BATCH, DEPTH, PAST_LEN, ROPE_B)),
        'cache_diff_k': nrm((DEC_BATCH, DEPTH, PAST_LEN, H_C, 2, D_C)),
        'cache_diff_v': nrm((DEC_BATCH, DEPTH, PAST_LEN, H_C, 2 * D_C)),
        'c': nrm((DEC_BATCH, D)),
        'c_ctx': nrm((D,)),
        'w_mod': nrm((DEPTH, D, 6 * D), 0.5 * D ** -0.5),
        'b_mod': nrm((DEPTH, 6 * D), 0.02),
        'g_norm1': gain((DEPTH, D)),
        'g_norm2': gain((DEPTH, D)),
        'w_in': nrm((DEPTH, D, IN_COLS), D ** -0.5),
        'w_gla_a2': nrm((DEPTH, 2, GATE_RANK, H_A * DK_A), GATE_RANK ** -0.5),
        'b_gla_a': nrm((DEPTH, 2, H_A * DK_A), 0.1),
        'g_gla_out': gain((DEPTH, DV_A)),
        'g_mla_qa': gain((DEPTH, Q_RANK)),
        'g_mla_kva': gain((DEPTH, KV_RANK)),
        'w_mla_uq': nrm((DEPTH, Q_RANK, H_B * QK_B), Q_RANK ** -0.5),
        'w_mla_uk': nrm((DEPTH, KV_RANK, H_B * NOPE_B), KV_RANK ** -0.5),
        'w_mla_uv': nrm((DEPTH, KV_RANK, H_B * V_B), KV_RANK ** -0.5),
        'g_mla_q': gain((DEPTH, QK_B)),
        'g_mla_k': gain((DEPTH, QK_B)),
        'g_diff_q': gain((DEPTH, D_C)),
        'g_diff_k': gain((DEPTH, D_C)),
        'lam_qk': nrm((DEPTH, 4, D_C), 0.1),
        'g_diff_sub': gain((DEPTH, 2 * D_C)),
        'w_o_gla': nrm((DEPTH, W_A, D), W_A ** -0.5),
        'w_o_mla': nrm((DEPTH, W_B, D), W_B ** -0.5),
        'w_o_diff': nrm((DEPTH, W_C, D), W_C ** -0.5),
        'w_out': nrm((DEPTH, D, D), D ** -0.5),
        'w_mlp1': nrm((DEPTH, D, D_FF), D ** -0.5),
        'w_mlp2': nrm((DEPTH, D_FF, D), D_FF ** -0.5),
    }


def reference(x_prompt, x_sample, state_gla, cache_mla_ckv, cache_mla_krope, cache_diff_k, cache_diff_v, c, c_ctx, w_mod, b_mod, g_norm1, g_norm2, w_in, w_gla_a2, b_gla_a, g_gla_out, g_mla_qa, g_mla_kva, w_mla_uq, w_mla_uk, w_mla_uv, g_mla_q, g_mla_k, g_diff_q, g_diff_k, lam_qk, g_diff_sub, w_o_gla, w_o_mla, w_o_diff, w_out, w_mlp1, w_mlp2):
    y_prompt = x_prompt
    y_sample = x_sample
    ctx_cond = c_ctx[None, None, :]
    lat_cond = c[:, None, :]
    st_gla, st_ckv, st_krope, st_dk, st_dv = [], [], [], [], []
    for l in range(DEPTH):
        lp = dict(w_mod=w_mod[l], b_mod=b_mod[l], g_norm1=g_norm1[l], g_norm2=g_norm2[l], w_in=w_in[l], w_gla_a2=w_gla_a2[l], b_gla_a=b_gla_a[l], g_gla_out=g_gla_out[l], g_mla_qa=g_mla_qa[l], g_mla_kva=g_mla_kva[l], w_mla_uq=w_mla_uq[l], w_mla_uk=w_mla_uk[l], w_mla_uv=w_mla_uv[l], g_mla_q=g_mla_q[l], g_mla_k=g_mla_k[l], g_diff_q=g_diff_q[l], g_diff_k=g_diff_k[l], lam_qk=lam_qk[l], g_diff_sub=g_diff_sub[l], w_o_gla=w_o_gla[l], w_o_mla=w_o_mla[l], w_o_diff=w_o_diff[l], w_out=w_out[l], w_mlp1=w_mlp1[l], w_mlp2=w_mlp2[l])
        lam_init = 0.8 - 0.6 * math.exp(-0.3 * l)
        y_prompt, st = layer(y_prompt, ctx_cond, lp, lam_init, None)
        st_gla.append(st[0])
        st_ckv.append(st[1])
        st_krope.append(st[2])
        st_dk.append(st[3])
        st_dv.append(st[4])
        cached = (state_gla[:, l], cache_mla_ckv[:, l], cache_mla_krope[:, l], cache_diff_k[:, l], cache_diff_v[:, l])
        y_sample, _ = layer(y_sample, lat_cond, lp, lam_init, cached)
    new_state_gla = jnp.stack(st_gla, axis=1)
    new_mla_ckv = jnp.stack(st_ckv, axis=1)
    new_mla_krope = jnp.stack(st_krope, axis=1)
    new_diff_k = jnp.stack(st_dk, axis=1)
    new_diff_v = jnp.stack(st_dv, axis=1)
    return (y_prompt, y_sample, new_state_gla, new_mla_ckv, new_mla_krope, new_diff_k, new_diff_v)
```

```cpp
#include <hip/hip_runtime.h>
#include <hip/hip_cooperative_groups.h>
#include <cstdio>
#include <cstdint>
namespace cg = cooperative_groups;

#ifndef MULTI_LAUNCH
#define MULTI_LAUNCH 0
#endif

typedef unsigned short u16;
typedef __attribute__((ext_vector_type(8))) short bf16x8;
typedef __attribute__((ext_vector_type(4))) short s16x4;
typedef __attribute__((ext_vector_type(4))) float f32x4;
#define DI __device__ __forceinline__
#define LDSP(T, p) ((__attribute__((address_space(3))) T*)(p))

constexpr int D = 1024, DEPTH = 2;
constexpr int INC = 6848, INP = 6912;
constexpr int cAQ = 0, cAK = 256, cAV = 512, cAR = 1024, cAA = 1536, cQD = 1568, cKVD = 1952, cKR = 2208, cDQ = 2240, cDK = 2752, cDV = 3264, cGT = 3776;
constexpr int NJ = 4, TJ = 5120, KRJ = 5376, NCH = 80;
constexpr int NPH = 11;
constexpr float EPS = 1e-6f;
constexpr float LOG2E = 1.4426950408889634f;
constexpr float QS_M = 0.10206207261596575f * LOG2E;
constexpr float QS_D = 0.125f * LOG2E;

constexpr size_t O_GLA = 20971520, O_CKV = 23068672, O_KR = 25165824, O_DK = 25427968, O_DV = 29622272;

constexpr size_t al(size_t x) { return (x + 255) & ~(size_t)255; }
constexpr size_t W_IN = 0;
constexpr size_t W_UQ = W_IN + al((size_t)2 * INP * 1024 * 2);
constexpr size_t W_UKV = W_UQ + al((size_t)2 * 768 * 384 * 2);
constexpr size_t W_O = W_UKV + al((size_t)2 * 1024 * 256 * 2);
constexpr size_t W_OUT = W_O + al((size_t)6 * 1024 * 512 * 2);
constexpr size_t W_1 = W_OUT + al((size_t)2 * 1024 * 1024 * 2);
constexpr size_t W_2 = W_1 + al((size_t)2 * 4096 * 1024 * 2);
constexpr size_t B_MOD = W_2 + al((size_t)2 * 4096 * 1024 * 2);
constexpr size_t B_TAB = B_MOD + al((size_t)2 * 5 * 6144 * 4);
constexpr size_t B_H = B_TAB + al(16384);
constexpr size_t B_P = B_H + al((size_t)TJ * 1024 * 2);
constexpr size_t B_QB = B_P + al((size_t)TJ * INP * 2);
constexpr size_t B_CKV = B_QB + al((size_t)TJ * 768 * 2);
constexpr size_t B_KRB = B_CKV + al((size_t)KRJ * 256 * 2);
constexpr size_t B_KVR = B_KRB + al((size_t)KRJ * 32 * 2);
constexpr size_t B_KB = B_KVR + al((size_t)KRJ * 1024 * 2);
constexpr size_t B_KC = B_KB + al((size_t)KRJ * 768 * 2);
constexpr size_t B_VC = B_KC + al((size_t)KRJ * 512 * 2);
constexpr size_t B_U = B_VC + al((size_t)KRJ * 512 * 2);
constexpr size_t B_DEC = B_U + al((size_t)NCH * 8 * 8192 * 2);
constexpr size_t B_Y = B_DEC + al((size_t)NCH * 8 * 64 * 4);
constexpr size_t B_QC = B_Y + al((size_t)TJ * 1536 * 2);
constexpr size_t B_UP = B_QC + al((size_t)TJ * 512 * 2);
constexpr size_t B_RQ = B_UP + al((size_t)NCH * 8 * 8192 * 2);
constexpr size_t B_T = B_RQ + al((size_t)TJ * 4);
constexpr size_t WS_END = B_T + al((size_t)TJ * 1024 * 2);

struct Params {
  const float* in[34];
  float* out;
  char* ws;
};

DI int ltid() { int t = threadIdx.x; asm volatile("" : "+v"(t)); return t; }
DI float bf2f(u16 v) { return __uint_as_float(((unsigned)v) << 16); }
typedef __bf16 bf16v2 __attribute__((ext_vector_type(2)));
typedef float f32v2 __attribute__((ext_vector_type(2)));
DI unsigned pack2(float a, float b) { f32v2 v = {a, b}; return __builtin_bit_cast(unsigned, __builtin_convertvector(v, bf16v2)); }
DI u16 f2bf(float x) { return (u16)(pack2(x, 0.f) & 0xffffu); }
DI float wave_sum(float v) {
#pragma unroll
  for (int o = 32; o > 0; o >>= 1) v += __shfl_xor(v, o);
  return v;
}
DI float sigmoidf_(float x) { return 1.0f / (1.0f + __expf(-x)); }
DI f32x4 mfma16(bf16x8 a, bf16x8 b, f32x4 c) { return __builtin_amdgcn_mfma_f32_16x16x32_bf16(a, b, c, 0, 0, 0); }
DI s16x4 trr(const char* p) { return __builtin_amdgcn_ds_read_tr16_b64_v4i16(LDSP(s16x4, p)); }
DI bf16x8 tr_frag(const char* img, int stride, int k0, int n0, int lane) {
  const int g = lane >> 4, i = lane & 15;
  const char* p = img + (k0 + 8 * g + (i >> 2)) * stride + (n0 + 4 * (i & 3)) * 2;
  s16x4 lo = trr(p), hi = trr(p + 4 * stride);
  return __builtin_shufflevector(lo, hi, 0, 1, 2, 3, 4, 5, 6, 7);
}

struct Tok { int g, cond, b, s; bool lat; };
DI Tok tokinfo(int j, int r) {
  Tok t;
  if (r < 1024) { t.g = j * 1024 + r; t.cond = 0; t.b = t.g >> 8; t.s = t.g & 255; t.lat = false; }
  else { t.s = r - 1024; t.g = 4096 + j * 4096 + t.s; t.cond = 1 + j; t.b = j; t.lat = true; }
  return t;
}
DI int keyrow(int r) { return r < 1024 ? r : r + 256; }

DI void g_load(uint4 (&ra)[4], uint4 (&rb)[4], const u16* __restrict__ ga, const u16* __restrict__ gb, int lda, int ldb, int k0) {
#pragma unroll
  for (int i = 0; i < 4; ++i) { ra[i] = *(const uint4*)(ga + (size_t)i * 32 * lda + k0); rb[i] = *(const uint4*)(gb + (size_t)i * 32 * ldb + k0); }
}
DI void g_store(const uint4 (&ra)[4], const uint4 (&rb)[4], char* d, int soff) {
#pragma unroll
  for (int i = 0; i < 4; ++i) { *(uint4*)(d + soff + i * 4096) = ra[i]; *(uint4*)(d + 16384 + soff + i * 4096) = rb[i]; }
}
DI void g_compute(const char* sa, f32x4 (&acc)[4][4], int lane, int wm, int wn) {
  const char* sb = sa + 16384;
#pragma unroll
  for (int kk = 0; kk < 2; ++kk) {
    bf16x8 af[4], bfr[4];
    const int ch = kk * 4 + (lane >> 4);
#pragma unroll
    for (int mi = 0; mi < 4; ++mi) { const int row = wm * 64 + mi * 16 + (lane & 15); af[mi] = *(const bf16x8*)(sa + row * 128 + ((ch ^ (row & 7)) << 4)); }
#pragma unroll
    for (int ni = 0; ni < 4; ++ni) { const int row = wn * 64 + ni * 16 + (lane & 15); bfr[ni] = *(const bf16x8*)(sb + row * 128 + ((ch ^ (row & 7)) << 4)); }
#pragma unroll
    for (int mi = 0; mi < 4; ++mi)
#pragma unroll
      for (int ni = 0; ni < 4; ++ni) acc[mi][ni] = mfma16(bfr[ni], af[mi], acc[mi][ni]);
  }
}
template <bool DEEP = true>
DI void gemm_accum(const u16* __restrict__ A, int lda, const u16* __restrict__ Bt, int ldb, int K, char* smem, f32x4 (&acc)[4][4]) {
  const int tid = ltid(), lane = tid & 63, wid = tid >> 6, wm = wid >> 1, wn = wid & 1;
  const int srow = tid >> 3, skc = tid & 7;
  const int soff = srow * 128 + ((skc ^ (srow & 7)) << 4);
  const u16* ga = A + (size_t)srow * lda + skc * 8;
  const u16* gb = Bt + (size_t)srow * ldb + skc * 8;
  const int nk = K >> 6;
  const int klast = (nk - 1) << 6;
  if (DEEP) {
    uint4 p0, p1, p2, p3, p4, p5, p6, p7, q0, q1, q2, q3, q4, q5, q6, q7;
#define GL(a0, a1, a2, a3, b0, b1, b2, b3, k0_) do { const int kk_ = (k0_); \
      a0 = *(const uint4*)(ga + kk_); a1 = *(const uint4*)(ga + (size_t)32 * lda + kk_); a2 = *(const uint4*)(ga + (size_t)64 * lda + kk_); a3 = *(const uint4*)(ga + (size_t)96 * lda + kk_); \
      b0 = *(const uint4*)(gb + kk_); b1 = *(const uint4*)(gb + (size_t)32 * ldb + kk_); b2 = *(const uint4*)(gb + (size_t)64 * ldb + kk_); b3 = *(const uint4*)(gb + (size_t)96 * ldb + kk_); } while (0)
#define GS(a0, a1, a2, a3, b0, b1, b2, b3, d_) do { char* dd_ = (d_) + soff; \
      *(uint4*)(dd_) = a0; *(uint4*)(dd_ + 4096) = a1; *(uint4*)(dd_ + 8192) = a2; *(uint4*)(dd_ + 12288) = a3; \
      *(uint4*)(dd_ + 16384) = b0; *(uint4*)(dd_ + 20480) = b1; *(uint4*)(dd_ + 24576) = b2; *(uint4*)(dd_ + 28672) = b3; } while (0)
    GL(p0, p1, p2, p3, p4, p5, p6, p7, 0);
    GL(q0, q1, q2, q3, q4, q5, q6, q7, 64);
    GS(p0, p1, p2, p3, p4, p5, p6, p7, smem);
    __syncthreads();
#pragma unroll 1
    for (int kt = 0; kt < nk; kt += 2) {
      GL(p0, p1, p2, p3, p4, p5, p6, p7, min((kt + 2) << 6, klast));
      g_compute(smem, acc, lane, wm, wn);
      GS(q0, q1, q2, q3, q4, q5, q6, q7, smem + 32768);
      __syncthreads();
      GL(q0, q1, q2, q3, q4, q5, q6, q7, min((kt + 3) << 6, klast));
      g_compute(smem + 32768, acc, lane, wm, wn);
      GS(p0, p1, p2, p3, p4, p5, p6, p7, smem);
      __syncthreads();
    }
#undef GL
#undef GS
  } else {
    uint4 ra0[4], rb0[4];
    g_load(ra0, rb0, ga, gb, lda, ldb, 0);
    g_store(ra0, rb0, smem, soff);
    __syncthreads();
#pragma unroll 1
    for (int kt = 0; kt < nk; kt += 2) {
      g_load(ra0, rb0, ga, gb, lda, ldb, (kt + 1) << 6);
      g_compute(smem, acc, lane, wm, wn);
      g_store(ra0, rb0, smem + 32768, soff);
      __syncthreads();
      g_load(ra0, rb0, ga, gb, lda, ldb, min((kt + 2) << 6, klast));
      g_compute(smem + 32768, acc, lane, wm, wn);
      g_store(ra0, rb0, smem, soff);
      __syncthreads();
    }
  }
}
#define RAW_BARRIER() do { asm volatile("s_waitcnt lgkmcnt(0)" ::: "memory"); __builtin_amdgcn_s_barrier(); asm volatile("" ::: "memory"); } while (0)
DI void gemm_accum_glds(const u16* __restrict__ A, int lda, const u16* __restrict__ Bt, int ldb, int K, char* smem, f32x4 (&acc)[4][4]) {
  const int tid = ltid(), lane = tid & 63, wid = tid >> 6, wm = wid >> 1, wn = wid & 1;
  const int prow = lane >> 3, pkc = (lane & 7) ^ prow;
  const u16* ga = A + (size_t)(wid * 32 + prow) * lda + pkc * 8;
  const u16* gb = Bt + (size_t)(wid * 32 + 8 * (prow >> 2) + (prow & 3)) * ldb + pkc * 8;
  const int nk = K >> 6;
  const int klast = (nk - 1) << 6;
  const int fq = lane >> 4, fr = lane & 15;
  const unsigned sbase = (unsigned)(size_t)smem;
  const unsigned f0 = (unsigned)(fr * 128 + ((fq ^ (fr & 7)) << 4)), f1 = (unsigned)(fr * 128 + (((fq ^ (fr & 7)) ^ 4) << 4));
#define GLDS_TILE(k0_, st_) do { char* sb_ = smem + (st_) * 32768 + wid * 4096; const int kk_ = (k0_); \
    __builtin_amdgcn_global_load_lds((const unsigned*)(ga + kk_), (unsigned*)(sb_), 16, 0, 0); \
    __builtin_amdgcn_global_load_lds((const unsigned*)(ga + (size_t)8 * lda + kk_), (unsigned*)(sb_ + 1024), 16, 0, 0); \
    __builtin_amdgcn_global_load_lds((const unsigned*)(ga + (size_t)16 * lda + kk_), (unsigned*)(sb_ + 2048), 16, 0, 0); \
    __builtin_amdgcn_global_load_lds((const unsigned*)(ga + (size_t)24 * lda + kk_), (unsigned*)(sb_ + 3072), 16, 0, 0); \
    __builtin_amdgcn_global_load_lds((const unsigned*)(gb + kk_), (unsigned*)(sb_ + 16384), 16, 0, 0); \
    __builtin_amdgcn_global_load_lds((const unsigned*)(gb + (size_t)16 * ldb + kk_), (unsigned*)(sb_ + 16384 + 1024), 16, 0, 0); \
    __builtin_amdgcn_global_load_lds((const unsigned*)(gb + (size_t)4 * ldb + kk_), (unsigned*)(sb_ + 16384 + 2048), 16, 0, 0); \
    __builtin_amdgcn_global_load_lds((const unsigned*)(gb + (size_t)20 * ldb + kk_), (unsigned*)(sb_ + 16384 + 3072), 16, 0, 0); } while (0)
  RAW_BARRIER();
  GLDS_TILE(0, 0);
#pragma unroll 1
  for (int kt = 0; kt < nk; ++kt) {
    asm volatile("s_waitcnt vmcnt(0)" ::: "memory");
    RAW_BARRIER();
    GLDS_TILE(min((kt + 1) << 6, klast), (kt + 1) & 1);
    const unsigned st = sbase + (unsigned)((kt & 1) * 32768);
    const unsigned a0 = st + (unsigned)(wm * 8192) + f0, a1 = st + (unsigned)(wm * 8192) + f1;
    const unsigned b0 = st + 16384u + (unsigned)(wn * 8192) + f0, b1 = st + 16384u + (unsigned)(wn * 8192) + f1;
    bf16x8 af[4], bfr[4], ag[4], bg[4];
    asm volatile(
        "ds_read_b128 %0, %16\n\t"
        "ds_read_b128 %1, %16 offset:2048\n\t"
        "ds_read_b128 %2, %16 offset:4096\n\t"
        "ds_read_b128 %3, %16 offset:6144\n\t"
        "ds_read_b128 %4, %17\n\t"
        "ds_read_b128 %5, %17 offset:2048\n\t"
        "ds_read_b128 %6, %17 offset:4096\n\t"
        "ds_read_b128 %7, %17 offset:6144\n\t"
        "ds_read_b128 %8, %18\n\t"
        "ds_read_b128 %9, %18 offset:2048\n\t"
        "ds_read_b128 %10, %18 offset:4096\n\t"
        "ds_read_b128 %11, %18 offset:6144\n\t"
        "ds_read_b128 %12, %19\n\t"
        "ds_read_b128 %13, %19 offset:2048\n\t"
        "ds_read_b128 %14, %19 offset:4096\n\t"
        "ds_read_b128 %15, %19 offset:6144\n\t"
        "s_waitcnt lgkmcnt(8)"
        : "=&v"(af[0]), "=&v"(af[1]), "=&v"(af[2]), "=&v"(af[3]), "=&v"(bfr[0]), "=&v"(bfr[1]), "=&v"(bfr[2]), "=&v"(bfr[3]),
          "=&v"(ag[0]), "=&v"(ag[1]), "=&v"(ag[2]), "=&v"(ag[3]), "=&v"(bg[0]), "=&v"(bg[1]), "=&v"(bg[2]), "=&v"(bg[3])
        : "v"(a0), "v"(b0), "v"(a1), "v"(b1)
        : "memory");
#pragma unroll
    for (int mi = 0; mi < 4; ++mi)
#pragma unroll
      for (int ni = 0; ni < 4; ++ni) acc[mi][ni] = mfma16(bfr[ni], af[mi], acc[mi][ni]);
    asm volatile("s_waitcnt lgkmcnt(0)" : "+v"(ag[0]), "+v"(ag[1]), "+v"(ag[2]), "+v"(ag[3]), "+v"(bg[0]), "+v"(bg[1]), "+v"(bg[2]), "+v"(bg[3]), "+v"(acc[2][3]) :: "memory");
#pragma unroll
    for (int mi = 0; mi < 4; ++mi)
#pragma unroll
      for (int ni = 0; ni < 4; ++ni) acc[mi][ni] = mfma16(bg[ni], ag[mi], acc[mi][ni]);
  }
  asm volatile("s_waitcnt vmcnt(0)" ::: "memory");
  RAW_BARRIER();
#undef GLDS_TILE
}
DI void gemm80_glds(const u16* __restrict__ A, int lda, const u16* __restrict__ Bt, int ldb, int K, char* smem, f32x4 (&acc)[5][2]) {
  const int tid = ltid(), lane = tid & 63, wid = tid >> 6;
  const int prow = lane >> 3, pkc = (lane & 7) ^ prow;
  const u16* ga = A + (size_t)(wid * 8 + prow) * lda + pkc * 8;
  const u16* gb = Bt + (size_t)(wid * 32 + 8 * (prow >> 2) + (prow & 3)) * ldb + pkc * 8;
  const int nk = K >> 6;
  const int fq = lane >> 4, fr = lane & 15;
  const unsigned sbase = (unsigned)(size_t)smem;
  const unsigned f0 = (unsigned)(fr * 128 + ((fq ^ (fr & 7)) << 4)), f1 = (unsigned)(fr * 128 + (((fq ^ (fr & 7)) ^ 4) << 4));
#define GLDS80(k0_, st_) do { char* sa_ = smem + (st_) * 32768 + wid * 1024; char* sb_ = smem + (st_) * 32768 + 16384 + wid * 4096; const int kk_ = (k0_); \
    __builtin_amdgcn_global_load_lds((const unsigned*)(ga + kk_), (unsigned*)(sa_), 16, 0, 0); \
    __builtin_amdgcn_global_load_lds((const unsigned*)(ga + (size_t)32 * lda + kk_), (unsigned*)(sa_ + 4096), 16, 0, 0); \
    if (wid < 2) __builtin_amdgcn_global_load_lds((const unsigned*)(ga + (size_t)64 * lda + kk_), (unsigned*)(sa_ + 8192), 16, 0, 0); \
    __builtin_amdgcn_global_load_lds((const unsigned*)(gb + kk_), (unsigned*)(sb_), 16, 0, 0); \
    __builtin_amdgcn_global_load_lds((const unsigned*)(gb + (size_t)16 * ldb + kk_), (unsigned*)(sb_ + 1024), 16, 0, 0); \
    __builtin_amdgcn_global_load_lds((const unsigned*)(gb + (size_t)4 * ldb + kk_), (unsigned*)(sb_ + 2048), 16, 0, 0); \
    __builtin_amdgcn_global_load_lds((const unsigned*)(gb + (size_t)20 * ldb + kk_), (unsigned*)(sb_ + 3072), 16, 0, 0); } while (0)
  RAW_BARRIER();
  GLDS80(0, 0);
#pragma unroll 1
  for (int kt = 0; kt < nk; ++kt) {
    asm volatile("s_waitcnt vmcnt(0)" ::: "memory");
    RAW_BARRIER();
    if (kt + 1 < nk) GLDS80((kt + 1) << 6, (kt + 1) & 1);
    const unsigned st = sbase + (unsigned)((kt & 1) * 32768);
    const unsigned a0 = st + f0, a1 = st + f1;
    const unsigned b0 = st + 16384u + (unsigned)(wid * 4096) + f0, b1 = st + 16384u + (unsigned)(wid * 4096) + f1;
    bf16x8 af[5], bfr[2], ag[5], bg[2];
    asm volatile(
        "ds_read_b128 %0, %14\n\t"
        "ds_read_b128 %1, %14 offset:2048\n\t"
        "ds_read_b128 %2, %14 offset:4096\n\t"
        "ds_read_b128 %3, %14 offset:6144\n\t"
        "ds_read_b128 %4, %14 offset:8192\n\t"
        "ds_read_b128 %5, %15\n\t"
        "ds_read_b128 %6, %15 offset:2048\n\t"
        "ds_read_b128 %7, %16\n\t"
        "ds_read_b128 %8, %16 offset:2048\n\t"
        "ds_read_b128 %9, %16 offset:4096\n\t"
        "ds_read_b128 %10, %16 offset:6144\n\t"
        "ds_read_b128 %11, %16 offset:8192\n\t"
        "ds_read_b128 %12, %17\n\t"
        "ds_read_b128 %13, %17 offset:2048\n\t"
        "s_waitcnt lgkmcnt(7)"
        : "=&v"(af[0]), "=&v"(af[1]), "=&v"(af[2]), "=&v"(af[3]), "=&v"(af[4]), "=&v"(bfr[0]), "=&v"(bfr[1]),
          "=&v"(ag[0]), "=&v"(ag[1]), "=&v"(ag[2]), "=&v"(ag[3]), "=&v"(ag[4]), "=&v"(bg[0]), "=&v"(bg[1])
        : "v"(a0), "v"(b0), "v"(a1), "v"(b1)
        : "memory");
#pragma unroll
    for (int mi = 0; mi < 5; ++mi)
#pragma unroll
      for (int ni = 0; ni < 2; ++ni) acc[mi][ni] = mfma16(bfr[ni], af[mi], acc[mi][ni]);
    asm volatile("s_waitcnt lgkmcnt(0)" : "+v"(ag[0]), "+v"(ag[1]), "+v"(ag[2]), "+v"(ag[3]), "+v"(ag[4]), "+v"(bg[0]), "+v"(bg[1]), "+v"(acc[3][1]) :: "memory");
#pragma unroll
    for (int mi = 0; mi < 5; ++mi)
#pragma unroll
      for (int ni = 0; ni < 2; ++ni) acc[mi][ni] = mfma16(bg[ni], ag[mi], acc[mi][ni]);
  }
  RAW_BARRIER();
#undef GLDS80
}
template <class F>
DI void epi80_foreach(const f32x4 (&acc)[5][2], F f) {
  const int lane = ltid() & 63, wid = ltid() >> 6;
#pragma unroll
  for (int mi = 0; mi < 5; ++mi)
#pragma unroll
    for (int ni = 0; ni < 2; ++ni) f(mi * 16 + (lane & 15), wid * 32 + (lane >> 4) * 8 + ni * 4, acc[mi][ni]);
}
DI void zero_acc80(f32x4 (&acc)[5][2]) {
#pragma unroll
  for (int mi = 0; mi < 5; ++mi)
#pragma unroll
    for (int ni = 0; ni < 2; ++ni) acc[mi][ni] = (f32x4){0.f, 0.f, 0.f, 0.f};
}
template <class F>
DI void epi_foreach(const f32x4 (&acc)[4][4], F f) {
  const int lane = ltid() & 63, wid = ltid() >> 6, wm = wid >> 1, wn = wid & 1;
#pragma unroll
  for (int mi = 0; mi < 4; ++mi)
#pragma unroll
    for (int ni = 0; ni < 4; ++ni) f(wm * 64 + mi * 16 + (lane & 15), wn * 64 + (ni >> 1) * 32 + (lane >> 4) * 8 + (ni & 1) * 4, acc[mi][ni]);
}
template <class F>
DI void epi_foreach8(const f32x4 (&acc)[4][4], F f) {
  const int lane = ltid() & 63, wid = ltid() >> 6, wm = wid >> 1, wn = wid & 1;
#pragma unroll
  for (int mi = 0; mi < 4; ++mi)
#pragma unroll
    for (int np = 0; np < 2; ++np) f(wm * 64 + mi * 16 + (lane & 15), wn * 64 + np * 32 + (lane >> 4) * 8, acc[mi][2 * np], acc[mi][2 * np + 1]);
}
DI void zero_acc(f32x4 (&acc)[4][4]) {
#pragma unroll
  for (int mi = 0; mi < 4; ++mi)
#pragma unroll
    for (int ni = 0; ni < 4; ++ni) acc[mi][ni] = (f32x4){0.f, 0.f, 0.f, 0.f};
}

DI void xpose_tile(const float* __restrict__ src, int N, int K, u16* __restrict__ dst, int k0, int n0, float* tile, const float* __restrict__ ksc) {
  const int tid = ltid();
  { const int n4 = (tid & 15) * 4, kr = tid >> 4;
    float4 v[4];
#pragma unroll
    for (int i = 0; i < 4; ++i) v[i] = *(const float4*)(src + (size_t)(k0 + i * 16 + kr) * N + n0 + n4);
#pragma unroll
    for (int i = 0; i < 4; ++i) {
      const int k = i * 16 + kr;
      const float sc = ksc ? ksc[k0 + k] : 1.f;
      float* t = tile + k * 65 + n4;
      t[0] = v[i].x * sc; t[1] = v[i].y * sc; t[2] = v[i].z * sc; t[3] = v[i].w * sc;
    } }
  __syncthreads();
  { const int k8 = (tid & 7) * 8, nn = tid >> 3;
#pragma unroll
    for (int i = 0; i < 2; ++i) {
      const int n = i * 32 + nn;
      float x[8];
#pragma unroll
      for (int e = 0; e < 8; ++e) x[e] = tile[(k8 + e) * 65 + n];
      uint4 o; o.x = pack2(x[0], x[1]); o.y = pack2(x[2], x[3]); o.z = pack2(x[4], x[5]); o.w = pack2(x[6], x[7]);
      *(uint4*)(dst + (size_t)(n0 + n) * K + k0 + k8) = o;
    } }
  __syncthreads();
}
constexpr int XT_PER_LAYER = 4536;
DI void xpose_item(const Params& p, int l, int r, char* smem) {
  char* ws = p.ws;
  const float* src; u16* dst; int K, N; const float* ksc = nullptr;
  if (r < 1712) { src = p.in[13] + (size_t)l * 1024 * INC; K = 1024; N = INC; dst = (u16*)(ws + W_IN) + (size_t)l * INP * 1024; }
  else if ((r -= 1712) < 72) { src = p.in[19] + (size_t)l * 384 * 768; K = 384; N = 768; dst = (u16*)(ws + W_UQ) + (size_t)l * 768 * 384; ksc = p.in[17] + l * 384; }
  else if ((r -= 72) < 32) { src = p.in[20] + (size_t)l * 256 * 512; K = 256; N = 512; dst = (u16*)(ws + W_UKV) + (size_t)l * 1024 * 256; }
  else if ((r -= 32) < 32) { src = p.in[21] + (size_t)l * 256 * 512; K = 256; N = 512; dst = (u16*)(ws + W_UKV) + (size_t)l * 1024 * 256 + 512 * 256; }
  else if ((r -= 32) < 128) { src = p.in[28] + (size_t)l * 512 * 1024; K = 512; N = 1024; dst = (u16*)(ws + W_O) + (size_t)(l * 3 + 0) * 1024 * 512; }
  else if ((r -= 128) < 128) { src = p.in[29] + (size_t)l * 512 * 1024; K = 512; N = 1024; dst = (u16*)(ws + W_O) + (size_t)(l * 3 + 1) * 1024 * 512; }
  else if ((r -= 128) < 128) { src = p.in[30] + (size_t)l * 512 * 1024; K = 512; N = 1024; dst = (u16*)(ws + W_O) + (size_t)(l * 3 + 2) * 1024 * 512; }
  else if ((r -= 128) < 256) { src = p.in[31] + (size_t)l * 1024 * 1024; K = 1024; N = 1024; dst = (u16*)(ws + W_OUT) + (size_t)l * 1024 * 1024; }
  else if ((r -= 256) < 1024) { src = p.in[32] + (size_t)l * 1024 * 4096; K = 1024; N = 4096; dst = (u16*)(ws + W_1) + (size_t)l * 4096 * 1024; }
  else { r -= 1024; src = p.in[33] + (size_t)l * 4096 * 1024; K = 4096; N = 1024; dst = (u16*)(ws + W_2) + (size_t)l * 1024 * 4096; }
  const int nkt = K >> 6;
  xpose_tile(src, N, K, dst, (r % nkt) * 64, (r / nkt) * 64, (float*)smem, ksc);
}
DI bool defer_l1() { return gridDim.x >= 512; }
DI void phase0(const Params& p, char* smem) {
  const int tid = ltid();
  char* ws = p.ws;
  const int n_mod = 192, n_x = (defer_l1() ? 1 : 2) * XT_PER_LAYER, n_items = n_mod + n_x + 1 + 2;
  for (int it0 = blockIdx.x; it0 < n_items; it0 += gridDim.x) {
    if (it0 < n_mod) {
      const int l = it0 / 96, n0 = (it0 % 96) * 64;
      float* sc = (float*)smem;
      float* red = sc + 5 * 1024;
      __syncthreads();
      for (int i = tid; i < 5 * 1024; i += 256) { const int c = i >> 10, k = i & 1023; const float x = c == 0 ? p.in[8][k] : p.in[7][(c - 1) * 1024 + k]; sc[i] = x * sigmoidf_(x); }
      __syncthreads();
      const int c4 = (tid & 15) * 4, kg = tid >> 4;
      float4 a0 = make_float4(0.f, 0.f, 0.f, 0.f), a1 = a0, a2 = a0, a3 = a0, a4 = a0;
      const float* w = p.in[9] + (size_t)l * 1024 * 6144 + n0 + c4;
#pragma unroll 16
      for (int k = kg * 64; k < kg * 64 + 64; ++k) {
        const float4 wv = *(const float4*)(w + (size_t)k * 6144);
        const float s0 = sc[k], s1 = sc[1024 + k], s2 = sc[2048 + k], s3 = sc[3072 + k], s4 = sc[4096 + k];
        a0.x += s0 * wv.x; a0.y += s0 * wv.y; a0.z += s0 * wv.z; a0.w += s0 * wv.w;
        a1.x += s1 * wv.x; a1.y += s1 * wv.y; a1.z += s1 * wv.z; a1.w += s1 * wv.w;
        a2.x += s2 * wv.x; a2.y += s2 * wv.y; a2.z += s2 * wv.z; a2.w += s2 * wv.w;
        a3.x += s3 * wv.x; a3.y += s3 * wv.y; a3.z += s3 * wv.z; a3.w += s3 * wv.w;
        a4.x += s4 * wv.x; a4.y += s4 * wv.y; a4.z += s4 * wv.z; a4.w += s4 * wv.w;
      }
      *(float4*)(red + (kg * 5 + 0) * 64 + c4) = a0; *(float4*)(red + (kg * 5 + 1) * 64 + c4) = a1; *(float4*)(red + (kg * 5 + 2) * 64 + c4) = a2;
      *(float4*)(red + (kg * 5 + 3) * 64 + c4) = a3; *(float4*)(red + (kg * 5 + 4) * 64 + c4) = a4;
      __syncthreads();
      for (int i = tid; i < 320; i += 256) {
        const int c = i >> 6, nn = i & 63;
        float sum = p.in[10][l * 6144 + n0 + nn];
#pragma unroll
        for (int g = 0; g < 16; ++g) sum += red[(g * 5 + c) * 64 + nn];
        ((float*)(ws + B_MOD))[(l * 5 + c) * 6144 + n0 + nn] = sum;
      }
      __syncthreads();
      continue;
    }
    const int it = it0 - n_mod;
    if (it < n_x) {
      xpose_item(p, it / XT_PER_LAYER, it % XT_PER_LAYER, smem);
    } else if (it == n_x) {
      float* tab = (float*)(ws + B_TAB);
      if (tid < 2) {
        const float* lq = p.in[26] + tid * 256;
        float s1 = 0.f, s2 = 0.f;
        for (int i = 0; i < 64; ++i) { s1 += lq[i] * lq[64 + i]; s2 += lq[128 + i] * lq[192 + i]; }
        const float lam_init = tid == 0 ? 0.2f : 0.35550906759096926f;
        tab[tid] = __expf(s1) - __expf(s2) + lam_init;
      }
      for (int i = tid; i < 64 * 8; i += 256) { const int pos = i >> 3, f = i & 7; const float inv = exp2f(-(float)f * (13.287712379549449f / 8.f)); const float a = (float)pos * inv; tab[16 + i * 2] = __cosf(a); tab[16 + i * 2 + 1] = __sinf(a); }
      for (int i = tid; i < 64 * 16; i += 256) { const int pos = i >> 4, f = i & 15; const float inv = exp2f(-(float)f * (13.287712379549449f / 16.f)); const float a = (float)pos * inv; tab[16 + 1024 + i * 2] = __cosf(a); tab[16 + 1024 + i * 2 + 1] = __sinf(a); }
    } else {
      const int l = it - (n_x + 1);
      uint4* z = (uint4*)((u16*)(ws + W_IN) + (size_t)l * INP * 1024 + (size_t)INC * 1024);
      for (int i = tid; i < 64 * 1024 * 2 / 16; i += 256) z[i] = make_uint4(0, 0, 0, 0);
    }
  }
}
#define TAB_LAM(ws) ((const float*)((ws) + B_TAB))
#define TAB_CSM(ws) ((const float*)((ws) + B_TAB) + 16)
#define TAB_CSD(ws) ((const float*)((ws) + B_TAB) + 16 + 1024)

DI void ph_normmod(const Params& p, int l, int j, int which) {
  const int wave = ltid() >> 6, lane = ltid() & 63;
  const float* gn = p.in[which ? 12 : 11] + l * 1024;
  u16* H = (u16*)(p.ws + B_H);
  const int step = (int)gridDim.x * 4;
  for (int rb = blockIdx.x * 4 + wave; rb < TJ; rb += 3 * step) {
    float4 v[3][4];
#pragma unroll
    for (int q = 0; q < 3; ++q) {
      const int r = rb + q * step;
      if (r < TJ) {
        const Tok t = tokinfo(j, r);
        const float* x = (l == 0 && which == 0) ? (t.g < 4096 ? p.in[0] + (size_t)t.g * 1024 : p.in[1] + (size_t)(t.g - 4096) * 1024) : p.out + (size_t)t.g * 1024;
#pragma unroll
        for (int i = 0; i < 4; ++i) v[q][i] = *(const float4*)(x + (i >> 1) * 512 + lane * 8 + (i & 1) * 4);
      }
    }
#pragma unroll
    for (int q = 0; q < 3; ++q) {
      const int r = rb + q * step;
      if (r < TJ) {
        const Tok t = tokinfo(j, r);
        const float* md = (const float*)(p.ws + B_MOD) + (l * 5 + t.cond) * 6144;
        const float* sh = md + (which ? 3 : 0) * 1024;
        const float* sc = md + (which ? 4 : 1) * 1024;
        float ss = 0.f;
#pragma unroll
        for (int i = 0; i < 4; ++i) ss += v[q][i].x * v[q][i].x + v[q][i].y * v[q][i].y + v[q][i].z * v[q][i].z + v[q][i].w * v[q][i].w;
        ss = wave_sum(ss);
        const float rstd = rsqrtf(ss * (1.f / 1024.f) + EPS);
#pragma unroll
        for (int i2 = 0; i2 < 2; ++i2) {
          const int col = i2 * 512 + lane * 8;
          float y[8];
#pragma unroll
          for (int hlf = 0; hlf < 2; ++hlf) {
            const float4 g4 = *(const float4*)(gn + col + hlf * 4), s4 = *(const float4*)(sc + col + hlf * 4), h4 = *(const float4*)(sh + col + hlf * 4);
            const float4 vv = v[q][i2 * 2 + hlf];
            y[hlf * 4 + 0] = vv.x * rstd * g4.x * (1.f + s4.x) + h4.x; y[hlf * 4 + 1] = vv.y * rstd * g4.y * (1.f + s4.y) + h4.y;
            y[hlf * 4 + 2] = vv.z * rstd * g4.z * (1.f + s4.z) + h4.z; y[hlf * 4 + 3] = vv.w * rstd * g4.w * (1.f + s4.w) + h4.w;
          }
          uint4 o; o.x = pack2(y[0], y[1]); o.y = pack2(y[2], y[3]); o.z = pack2(y[4], y[5]); o.w = pack2(y[6], y[7]);
          *(uint4*)(H + (size_t)r * 1024 + col) = o;
        }
      }
    }
  }
}

constexpr int G_BS = 0;
constexpr int G_QT = 16640;
constexpr int G_AS = 17664;
constexpr int G_QP = 25856;
constexpr int G_KP = 35072;
constexpr int G_VS = 44288;
DI float logsig(float x) { return fminf(x, 0.f) - __logf(1.f + __expf(-fabsf(x))); }

DI void gla_stage(const Params& p, const u16* P, int row0, int h, char* smem) {
  const int tid = ltid();
  float* aS = (float*)(smem + G_AS);
#pragma unroll
  for (int i = 0; i < 8; ++i) { const int e = tid + i * 256, t = e >> 5, c = e & 31; aS[e] = bf2f(P[(size_t)(row0 + t) * INP + cAA + c]); }
#pragma unroll
  for (int i = 0; i < 4; ++i) { const int c = tid + i * 256, row = c >> 4, ch = c & 15; *(uint4*)(smem + G_VS + row * 272 + ch * 16) = *(const uint4*)(P + (size_t)(row0 + row) * INP + cAV + h * 128 + ch * 8); }
  __syncthreads();
}
DI void gla_load_w(const Params& p, int l, int h, int dir, float (&wa)[16], float& bias) {
  const int d = ltid() & 63;
  const float* w = p.in[14] + (size_t)((l * 2 + dir) * 16) * 256 + h * 64 + d;
#pragma unroll
  for (int r = 0; r < 16; ++r) wa[r] = w[r * 256];
  bias = p.in[15][(l * 2 + dir) * 256 + h * 64 + d];
}
DI void gla_cum(int dir, char* smem, const float (&wa0)[16], const float (&wa1)[16], float b0, float b1) {
  const int tid = ltid(), d = tid & 63, tq = tid >> 6;
  float* bS = (float*)(smem + G_BS); float* qt = (float*)(smem + G_QT); const float* aS = (const float*)(smem + G_AS);
  float wa[16];
#pragma unroll
  for (int r = 0; r < 16; ++r) wa[r] = dir ? wa1[r] : wa0[r];
  const float bias = dir ? b1 : b0;
  float run = 0.f;
#pragma unroll
  for (int ii = 0; ii < 16; ++ii) {
    const int t = tq * 16 + (dir ? 15 - ii : ii);
    float lg = bias;
#pragma unroll
    for (int r = 0; r < 16; ++r) lg += aS[t * 32 + dir * 16 + r] * wa[r];
    run += logsig(lg) * (1.f / 16.f);
    bS[t * 65 + d] = run;
  }
  qt[tq * 64 + d] = run;
  __syncthreads();
  float off = 0.f;
#pragma unroll
  for (int q = 0; q < 4; ++q) { const bool take = dir ? (q > tq) : (q < tq); off += take ? qt[q * 64 + d] : 0.f; }
#pragma unroll
  for (int ii = 0; ii < 16; ++ii) { const int t = tq * 16 + ii; bS[t * 65 + d] += off; }
  __syncthreads();
}

DI void gla_g1_item(const Params& p, int l, int c, int h, char* smem) {
  const int tid = ltid(), lane = tid & 63, w = tid >> 6, d = tid & 63, tq = tid >> 6;
  const u16* P = (const u16*)(p.ws + B_P);
  const int row0 = c * 64;
  float kreg[16];
#pragma unroll
  for (int ii = 0; ii < 16; ++ii) kreg[ii] = bf2f(P[(size_t)(row0 + tq * 16 + ii) * INP + cAK + h * 64 + d]);
  float wa0[16], wa1[16], wb0, wb1;
  gla_load_w(p, l, h, 0, wa0, wb0); gla_load_w(p, l, h, 1, wa1, wb1);
  gla_stage(p, P, row0, h, smem);
  const float* bS = (const float*)(smem + G_BS);
  for (int dir = 0; dir < 2; ++dir) {
    gla_cum(dir, smem, wa0, wa1, wb0, wb1);
    const float bend = dir ? bS[d] : bS[63 * 65 + d];
#pragma unroll
    for (int ii = 0; ii < 16; ++ii) {
      const int t = tq * 16 + ii;
      *(u16*)(smem + G_KP + t * 144 + d * 2) = f2bf(kreg[ii] * __expf(bend - bS[t * 65 + d]));
    }
    if (tq == 0) ((float*)(p.ws + B_DEC))[((c * 4 + h) * 2 + dir) * 64 + d] = __expf(bend);
    __syncthreads();
    f32x4 acc[2][4];
#pragma unroll
    for (int a = 0; a < 2; ++a)
#pragma unroll
      for (int b = 0; b < 4; ++b) acc[a][b] = (f32x4){0.f, 0.f, 0.f, 0.f};
#pragma unroll
    for (int ks = 0; ks < 2; ++ks) {
      bf16x8 bfr[4];
#pragma unroll
      for (int nt = 0; nt < 4; ++nt) bfr[nt] = tr_frag(smem + G_KP, 144, ks * 32, nt * 16, lane);
#pragma unroll
      for (int vi = 0; vi < 2; ++vi) {
        const bf16x8 af = tr_frag(smem + G_VS, 272, ks * 32, (2 * w + vi) * 16, lane);
#pragma unroll
        for (int nt = 0; nt < 4; ++nt) acc[vi][nt] = mfma16(af, bfr[nt], acc[vi][nt]);
      }
    }
    u16* U = (u16*)(p.ws + B_U) + (size_t)((c * 4 + h) * 2 + dir) * 8192;
#pragma unroll
    for (int vi = 0; vi < 2; ++vi)
#pragma unroll
      for (int nt = 0; nt < 4; ++nt)
#pragma unroll
        for (int jj = 0; jj < 4; ++jj) U[((2 * w + vi) * 16 + (lane >> 4) * 4 + jj) * 64 + nt * 16 + (lane & 15)] = f2bf(acc[vi][nt][jj]);
    __syncthreads();
  }
}

template <int BT>
DI void g2_scan(const u16* __restrict__ U, u16* __restrict__ UP, const float* __restrict__ DEC, int c_lo, int c_hi, int h, int dir, int d, int e, float& s) {
  const int n = c_hi - c_lo;
  for (int i0 = 0; i0 < n; i0 += BT) {
    float tmp[BT], dc[BT];
#pragma unroll
    for (int k = 0; k < BT; ++k) {
      const int c = dir ? (c_hi - 1 - i0 - k) : (c_lo + i0 + k);
      tmp[k] = bf2f(U[(size_t)((c * 4 + h) * 2 + dir) * 8192 + e]); dc[k] = DEC[((c * 4 + h) * 2 + dir) * 64 + d];
    }
#pragma unroll
    for (int k = 0; k < BT; ++k) {
      const int c = dir ? (c_hi - 1 - i0 - k) : (c_lo + i0 + k);
      UP[(size_t)((c * 4 + h) * 2 + dir) * 8192 + e] = f2bf(s); s = dc[k] * s + tmp[k];
    }
  }
}
DI void gla_g2_item(const Params& p, int l, int j, int q) {
  const int tid = ltid();
  int c_lo, c_hi, hd, e, b; bool lat;
  if (q < 256) { lat = true; hd = q >> 5; e = (q & 31) * 256 + tid; c_lo = 16; c_hi = 80; b = j; }
  else { const int qq = q - 256; lat = false; const int sq = qq >> 8; hd = (qq >> 5) & 7; e = (qq & 31) * 256 + tid; c_lo = sq * 4; c_hi = c_lo + 4; b = j * 4 + sq; }
  const int h = hd >> 1, dir = hd & 1, d = e & 63, v = e >> 6;
  float s = lat ? p.in[2][((size_t)(((b * 2 + l) * 2 + dir) * 4 + h) * 64 + d) * 128 + v] : 0.f;
  const u16* U = (const u16*)(p.ws + B_U); u16* UP = (u16*)(p.ws + B_UP); const float* DEC = (const float*)(p.ws + B_DEC);
  if (lat) g2_scan<32>(U, UP, DEC, c_lo, c_hi, h, dir, d, e, s);
  else g2_scan<4>(U, UP, DEC, c_lo, c_hi, h, dir, d, e, s);
  if (!lat) p.out[O_GLA + ((size_t)(((b * 2 + l) * 2 + dir) * 4 + h) * 64 + d) * 128 + v] = s;
}

DI void gla_g3_item(const Params& p, int l, int c, int h, char* smem) {
  const int tid = ltid(), lane = tid & 63, w = tid >> 6, d = tid & 63, tq = tid >> 6;
  const u16* P = (const u16*)(p.ws + B_P);
  const int row0 = c * 64;
  u16 rreg[4][8];
#pragma unroll
  for (int jj = 0; jj < 4; ++jj)
#pragma unroll
    for (int vt = 0; vt < 8; ++vt) rreg[jj][vt] = P[(size_t)(row0 + 16 * w + (lane >> 4) * 4 + jj) * INP + cAR + h * 128 + vt * 16 + (lane & 15)];
  float qreg[16], kreg[16];
#pragma unroll
  for (int ii = 0; ii < 16; ++ii) {
    qreg[ii] = bf2f(P[(size_t)(row0 + tq * 16 + ii) * INP + cAQ + h * 64 + d]) * 0.125f;
    kreg[ii] = bf2f(P[(size_t)(row0 + tq * 16 + ii) * INP + cAK + h * 64 + d]);
  }
  float wa0[16], wa1[16], wb0, wb1;
  gla_load_w(p, l, h, 0, wa0, wb0); gla_load_w(p, l, h, 1, wa1, wb1);
  gla_stage(p, P, row0, h, smem);
  const float* bS = (const float*)(smem + G_BS);
  f32x4 o[8];
#pragma unroll
  for (int vt = 0; vt < 8; ++vt) o[vt] = (f32x4){0.f, 0.f, 0.f, 0.f};
  for (int dir = 0; dir < 2; ++dir) {
    gla_cum(dir, smem, wa0, wa1, wb0, wb1);
#pragma unroll
    for (int ii = 0; ii < 16; ++ii) {
      const int t = tq * 16 + ii;
      const float bb = bS[t * 65 + d];
      *(u16*)(smem + G_QP + t * 144 + d * 2) = f2bf(qreg[ii] * __expf(bb));
      *(u16*)(smem + G_KP + t * 144 + d * 2) = f2bf(kreg[ii] * __expf(-bb));
    }
    __syncthreads();
    bf16x8 af[2];
#pragma unroll
    for (int ks = 0; ks < 2; ++ks) af[ks] = *(const bf16x8*)(smem + G_QP + (16 * w + (lane & 15)) * 144 + (ks * 32 + (lane >> 4) * 8) * 2);
#pragma unroll
    for (int nt = 0; nt < 4; ++nt) {
      f32x4 sa = (f32x4){0.f, 0.f, 0.f, 0.f};
#pragma unroll
      for (int ks = 0; ks < 2; ++ks) {
        const bf16x8 bk = *(const bf16x8*)(smem + G_KP + (nt * 16 + (lane & 15)) * 144 + (ks * 32 + (lane >> 4) * 8) * 2);
        sa = mfma16(af[ks], bk, sa);
      }
      const int sidx = nt * 16 + (lane & 15);
#pragma unroll
      for (int jj = 0; jj < 4; ++jj) {
        const int t = 16 * w + (lane >> 4) * 4 + jj;
        const bool keep = dir ? (sidx >= t) : (sidx <= t);
        *(u16*)(smem + G_BS + t * 144 + sidx * 2) = keep ? f2bf(sa[jj]) : (u16)0;
      }
    }
    __syncthreads();
    bf16x8 at[2];
#pragma unroll
    for (int ks = 0; ks < 2; ++ks) at[ks] = *(const bf16x8*)(smem + G_BS + (16 * w + (lane & 15)) * 144 + (ks * 32 + (lane >> 4) * 8) * 2);
    const u16* Up = (const u16*)(p.ws + B_UP) + (size_t)((c * 4 + h) * 2 + dir) * 8192;
#pragma unroll
    for (int vt = 0; vt < 8; ++vt) {
#pragma unroll
      for (int ks = 0; ks < 2; ++ks) {
        const bf16x8 bv = tr_frag(smem + G_VS, 272, ks * 32, vt * 16, lane);
        o[vt] = mfma16(at[ks], bv, o[vt]);
        const bf16x8 bs = *(const bf16x8*)(Up + (vt * 16 + (lane & 15)) * 64 + ks * 32 + (lane >> 4) * 8);
        o[vt] = mfma16(af[ks], bs, o[vt]);
      }
    }
    __syncthreads();
  }
  u16* Y = (u16*)(p.ws + B_Y);
  const float* go = p.in[16] + l * 128;
#pragma unroll
  for (int jj = 0; jj < 4; ++jj) {
    float ss = 0.f;
#pragma unroll
    for (int vt = 0; vt < 8; ++vt) ss += o[vt][jj] * o[vt][jj];
    ss += __shfl_xor(ss, 1); ss += __shfl_xor(ss, 2); ss += __shfl_xor(ss, 4); ss += __shfl_xor(ss, 8);
    const float rstd = rsqrtf(ss * (1.f / 128.f) + EPS);
    const int row = row0 + 16 * w + (lane >> 4) * 4 + jj;
#pragma unroll
    for (int vt = 0; vt < 8; ++vt) {
      const int v = vt * 16 + (lane & 15);
      const float r = bf2f(rreg[jj][vt]);
      Y[(size_t)row * 1536 + h * 128 + v] = f2bf(o[vt][jj] * rstd * go[v] * (r * sigmoidf_(r)));
    }
  }
}

DI void unpack8(const uint4 v, float* x) {
  x[0] = __uint_as_float(v.x << 16); x[1] = __uint_as_float(v.x & 0xffff0000u); x[2] = __uint_as_float(v.y << 16); x[3] = __uint_as_float(v.y & 0xffff0000u);
  x[4] = __uint_as_float(v.z << 16); x[5] = __uint_as_float(v.z & 0xffff0000u); x[6] = __uint_as_float(v.w << 16); x[7] = __uint_as_float(v.w & 0xffff0000u);
}
DI uint4 pack8(const float* x) { uint4 v; v.x = pack2(x[0], x[1]); v.y = pack2(x[2], x[3]); v.z = pack2(x[4], x[5]); v.w = pack2(x[6], x[7]); return v; }
DI void tokpost16(const Params& p, int l, int j, int r0) {
  const int tid = ltid();
  const u16* __restrict__ P = (const u16*)(p.ws + B_P);
  {
    const int r = r0 + (tid >> 4), u = tid & 15, grp = u & 7; const bool isk = u >= 8;
    const Tok t = tokinfo(j, r);
    const uint4* src = (const uint4*)(P + (size_t)r * INP + (isk ? cDK : cDQ) + grp * 64);
    uint4 v[8];
#pragma unroll
    for (int i = 0; i < 8; ++i) v[i] = src[i];
    float x[64]; float ss = 0.f;
#pragma unroll
    for (int i = 0; i < 8; ++i) unpack8(v[i], x + i * 8);
#pragma unroll
    for (int e = 0; e < 64; ++e) ss += x[e] * x[e];
    const float rstd = rsqrtf(ss * (1.f / 64.f) + EPS);
    const float* g = p.in[isk ? 25 : 24] + l * 64;
#pragma unroll
    for (int e = 0; e < 64; ++e) x[e] *= rstd * g[e];
    if (isk && !t.lat) {
      float4* o = (float4*)(p.out + O_DK + (size_t)((t.b * 2 + l) * 256 + t.s) * 512 + grp * 64);
#pragma unroll
      for (int i = 0; i < 16; ++i) o[i] = make_float4(x[i * 4], x[i * 4 + 1], x[i * 4 + 2], x[i * 4 + 3]);
    }
    if (t.lat) {
#pragma unroll
      for (int hh = 0; hh < 2; ++hh) {
        const int pos = hh ? (t.s & 63) : (t.s >> 6);
        const float* cs = TAB_CSD(p.ws) + pos * 32;
#pragma unroll
        for (int i = 0; i < 16; ++i) {
          const float a = x[hh * 32 + i], b = x[hh * 32 + 16 + i], c = cs[2 * i], sn = cs[2 * i + 1];
          x[hh * 32 + i] = a * c - b * sn; x[hh * 32 + 16 + i] = a * sn + b * c;
        }
      }
    }
    const float sc = isk ? 1.f : QS_D;
#pragma unroll
    for (int e = 0; e < 64; ++e) x[e] *= sc;
    uint4* dst = isk ? (uint4*)((u16*)(p.ws + B_KC) + (size_t)keyrow(r) * 512 + grp * 64) : (uint4*)((u16*)(p.ws + B_QC) + (size_t)r * 512 + grp * 64);
#pragma unroll
    for (int i = 0; i < 8; ++i) dst[i] = pack8(x + i * 8);
  }
  {
#pragma unroll
    for (int i = 0; i < 4; ++i) {
      const int c = tid + i * 256, r = r0 + (c >> 6), ch = c & 63;
      const Tok t = tokinfo(j, r);
      const uint4 v = *(const uint4*)(P + (size_t)r * INP + cDV + ch * 8);
      *(uint4*)((u16*)(p.ws + B_VC) + (size_t)keyrow(r) * 512 + ch * 8) = v;
      if (!t.lat) { float x[8]; unpack8(v, x); float4* o = (float4*)(p.out + O_DV + (size_t)((t.b * 2 + l) * 256 + t.s) * 512 + ch * 8); o[0] = make_float4(x[0], x[1], x[2], x[3]); o[1] = make_float4(x[4], x[5], x[6], x[7]); }
    }
    if (tid < 64) {
      const int r = r0 + (tid >> 2), ch = tid & 3;
      const Tok t = tokinfo(j, r);
      const uint4 v = *(const uint4*)(P + (size_t)r * INP + cKR + ch * 8);
      *(uint4*)((u16*)(p.ws + B_KRB) + (size_t)keyrow(r) * 32 + ch * 8) = v;
      if (!t.lat) { float x[8]; unpack8(v, x); float4* o = (float4*)(p.out + O_KR + (size_t)((t.b * 2 + l) * 256 + t.s) * 32 + ch * 8); o[0] = make_float4(x[0], x[1], x[2], x[3]); o[1] = make_float4(x[4], x[5], x[6], x[7]); }
    }
  }
  {
    const int r = r0 + (tid >> 4), u = tid & 15;
    const Tok t = tokinfo(j, r);
    const uint4* src = (const uint4*)(P + (size_t)r * INP + cKVD + u * 16);
    const uint4* sq = (const uint4*)(P + (size_t)r * INP + cQD + u * 24);
    const uint4 v0 = src[0], v1 = src[1], q0 = sq[0], q1 = sq[1], q2 = sq[2];
    float x[16], y[24];
    unpack8(v0, x); unpack8(v1, x + 8); unpack8(q0, y); unpack8(q1, y + 8); unpack8(q2, y + 16);
    float ss = 0.f, sq2 = 0.f;
#pragma unroll
    for (int e = 0; e < 16; ++e) ss += x[e] * x[e];
#pragma unroll
    for (int e = 0; e < 24; ++e) sq2 += y[e] * y[e];
    ss += __shfl_xor(ss, 1); ss += __shfl_xor(ss, 2); ss += __shfl_xor(ss, 4); ss += __shfl_xor(ss, 8);
    sq2 += __shfl_xor(sq2, 1); sq2 += __shfl_xor(sq2, 2); sq2 += __shfl_xor(sq2, 4); sq2 += __shfl_xor(sq2, 8);
    const float rstd = rsqrtf(ss * (1.f / 256.f) + EPS);
    const float* g = p.in[18] + l * 256 + u * 16;
#pragma unroll
    for (int e = 0; e < 16; ++e) x[e] *= rstd * g[e];
    uint4* dst = (uint4*)((u16*)(p.ws + B_CKV) + (size_t)keyrow(r) * 256 + u * 16);
    dst[0] = pack8(x); dst[1] = pack8(x + 8);
    if (!t.lat) {
      float4* o = (float4*)(p.out + O_CKV + (size_t)((t.b * 2 + l) * 256 + t.s) * 256 + u * 16);
#pragma unroll
      for (int i = 0; i < 4; ++i) o[i] = make_float4(x[i * 4], x[i * 4 + 1], x[i * 4 + 2], x[i * 4 + 3]);
    }
    if (u == 0) ((float*)(p.ws + B_RQ))[r] = sq2 * (1.f / 384.f);
  }
}
DI void cachepost(const Params& p, int l, int j, int pr, int lane) {
  const size_t rb = (size_t)((j * 2 + l) * 256 + pr);
  const int kr = 1024 + pr;
  u16* ck = (u16*)(p.ws + B_CKV) + (size_t)kr * 256;
#pragma unroll
  for (int i = 0; i < 4; ++i) ck[i * 64 + lane] = f2bf(p.in[3][rb * 256 + i * 64 + lane]);
  if (lane < 32) ((u16*)(p.ws + B_KRB))[(size_t)kr * 32 + lane] = f2bf(p.in[4][rb * 32 + lane]);
  u16* kc = (u16*)(p.ws + B_KC) + (size_t)kr * 512; u16* vc = (u16*)(p.ws + B_VC) + (size_t)kr * 512;
#pragma unroll
  for (int i = 0; i < 8; ++i) { kc[i * 64 + lane] = f2bf(p.in[5][rb * 512 + i * 64 + lane]); vc[i * 64 + lane] = f2bf(p.in[6][rb * 512 + i * 64 + lane]); }
}
DI void phaseC(const Params& p, int l, int j, char* smem) {
  const int wave = ltid() >> 6, lane = ltid() & 63;
  const int nG = NCH * 4, nT = TJ / 16, nC = 16, nQ = 40 * 6;
  const bool split = (int)gridDim.x >= nG + 128;
  const int step = split ? ((int)blockIdx.x < nG ? (1 << 20) : (int)gridDim.x - nG) : (int)gridDim.x;
  for (int it = blockIdx.x; it < nG + nT + nC + nQ; it += step) {
    if (it < nG) gla_g1_item(p, l, it >> 2, it & 3, smem);
    else if (it < nG + nT) tokpost16(p, l, j, (it - nG) * 16);
    else if (it < nG + nT + nC) { const int r0 = (it - nG - nT) * 16 + wave * 4; for (int i = 0; i < 4; ++i) cachepost(p, l, j, r0 + i, lane); }
    else {
      const int q = it - nG - nT - nC, mt = q % 40, nt = q / 40;
      f32x4 acc[4][4]; zero_acc(acc);
      gemm_accum_glds((const u16*)(p.ws + B_P) + (size_t)mt * 128 * INP + cQD, INP, (const u16*)(p.ws + W_UQ) + (size_t)l * 768 * 384 + (size_t)nt * 128 * 384, 384, 384, smem, acc);
      u16* QB = (u16*)(p.ws + B_QB);
      epi_foreach8(acc, [&](int row, int col, f32x4 v, f32x4 w) { uint4 o; o.x = pack2(v[0], v[1]); o.y = pack2(v[2], v[3]); o.z = pack2(w[0], w[1]); o.w = pack2(w[2], w[3]); *(uint4*)(QB + (size_t)(mt * 128 + row) * 768 + nt * 128 + col) = o; });
    }
  }
}

DI void phaseD(const Params& p, int l, int j, char* smem) {
  const int nG2a = 256, nQ = 0, nKV = 42 * 8, nG2b = 1024;
  const int lane = ltid() & 63; (void)lane;
  const int step = (int)gridDim.x;
  for (int it = blockIdx.x; it < nG2a + nQ + nKV + nG2b; it += step) {
    if (it < nG2a) gla_g2_item(p, l, j, it);
    else if (it < nG2a + nQ) {
    } else if (it < nG2a + nQ + nKV) {
      const int q = it - nG2a - nQ, mt = q % 42, nt = q / 42;
      f32x4 acc[4][4]; zero_acc(acc);
      gemm_accum_glds((const u16*)(p.ws + B_CKV) + (size_t)mt * 128 * 256, 256, (const u16*)(p.ws + W_UKV) + (size_t)l * 1024 * 256 + (size_t)nt * 128 * 256, 256, 256, smem, acc);
      u16* KVR = (u16*)(p.ws + B_KVR);
      epi_foreach8(acc, [&](int row, int col, f32x4 v, f32x4 w) { uint4 o; o.x = pack2(v[0], v[1]); o.y = pack2(v[2], v[3]); o.z = pack2(w[0], w[1]); o.w = pack2(w[2], w[3]); *(uint4*)(KVR + (size_t)(mt * 128 + row) * 1024 + nt * 128 + col) = o; });
    } else gla_g2_item(p, l, j, 256 + it - nG2a - nQ - nKV);
  }
}

DI void inproj_tile(const Params& p, int l, int mt, int nt, char* smem) {
  u16* P = (u16*)(p.ws + B_P);
  f32x4 acc[4][4]; zero_acc(acc);
  gemm_accum_glds((const u16*)(p.ws + B_H) + (size_t)mt * 128 * 1024, 1024, (const u16*)(p.ws + W_IN) + (size_t)l * INP * 1024 + (size_t)nt * 128 * 1024, 1024, 1024, smem, acc);
  epi_foreach8(acc, [&](int row, int col, f32x4 v, f32x4 w) { uint4 o; o.x = pack2(v[0], v[1]); o.y = pack2(v[2], v[3]); o.z = pack2(w[0], w[1]); o.w = pack2(w[2], w[3]); *(uint4*)(P + (size_t)(mt * 128 + row) * INP + nt * 128 + col) = o; });
}
constexpr int NT_B = 51;
DI void phaseE(const Params& p, int l, int j, char* smem) {
  const int tid = ltid();
  const int nG3 = NCH * 4, nQ = TJ * 8 / 256, nK = KRJ * 8 / 256;
  const bool split = (int)gridDim.x >= nG3 + 128;
  const int step = split ? ((int)blockIdx.x < nG3 ? (1 << 20) : (int)gridDim.x - nG3) : (int)gridDim.x;
  const int nIn = 40 * (54 - NT_B);
  for (int it0 = blockIdx.x; it0 < nG3 + nIn + nQ + nK; it0 += step) {
    if (it0 < nG3) { gla_g3_item(p, l, it0 >> 2, it0 & 3, smem); continue; }
    if (it0 < nG3 + nIn) { const int q = it0 - nG3; inproj_tile(p, l, q % 40, NT_B + q / 40, smem); continue; }
    const int it = it0 - nG3 - nIn;
    const bool isq = it < nQ;
    const int u = (isq ? it : it - nQ) * 256 + tid, r = u >> 3, h = u & 7;
    float x[96];
    if (isq) {
      const uint4* src = (const uint4*)((const u16*)(p.ws + B_QB) + (size_t)r * 768 + h * 96);
      uint4 v[12];
#pragma unroll
      for (int i = 0; i < 12; ++i) v[i] = src[i];
#pragma unroll
      for (int i = 0; i < 12; ++i) unpack8(v[i], x + i * 8);
    } else {
      const uint4* s0 = (const uint4*)((const u16*)(p.ws + B_KVR) + (size_t)r * 1024 + h * 64);
      const uint4* s1 = (const uint4*)((const u16*)(p.ws + B_KRB) + (size_t)r * 32);
      uint4 v[12];
#pragma unroll
      for (int i = 0; i < 8; ++i) v[i] = s0[i];
#pragma unroll
      for (int i = 0; i < 4; ++i) v[8 + i] = s1[i];
#pragma unroll
      for (int i = 0; i < 12; ++i) unpack8(v[i], x + i * 8);
    }
    float ss = 0.f;
#pragma unroll
    for (int e = 0; e < 96; ++e) ss += x[e] * x[e];
    const float eps2 = isq ? EPS * (((const float*)(p.ws + B_RQ))[r] + EPS) : EPS;
    const float rstd = rsqrtf(ss * (1.f / 96.f) + eps2);
    const float* g = p.in[isq ? 22 : 23] + l * 96;
#pragma unroll
    for (int e = 0; e < 96; ++e) x[e] *= rstd * g[e];
    const bool rope = isq ? (r >= 1024) : (r >= 1280);
    if (rope) {
      const int s = r - (isq ? 1024 : 1280);
#pragma unroll
      for (int hh = 0; hh < 2; ++hh) {
        const int pos = hh ? (s & 63) : (s >> 6);
        const float* cs = TAB_CSM(p.ws) + pos * 16;
#pragma unroll
        for (int i = 0; i < 8; ++i) {
          const float a = x[64 + hh * 16 + i], b = x[64 + hh * 16 + 8 + i], c = cs[2 * i], sn = cs[2 * i + 1];
          x[64 + hh * 16 + i] = a * c - b * sn; x[64 + hh * 16 + 8 + i] = a * sn + b * c;
        }
      }
    }
    const float sc = isq ? QS_M : 1.f;
#pragma unroll
    for (int e = 0; e < 96; ++e) x[e] *= sc;
    uint4* dst = isq ? (uint4*)((u16*)(p.ws + B_QB) + (size_t)r * 768 + h * 96) : (uint4*)((u16*)(p.ws + B_KB) + (size_t)r * 768 + h * 96);
#pragma unroll
    for (int i = 0; i < 12; ++i) dst[i] = pack8(x + i * 8);
  }
}

template <int DQK, int DV, int NQT>
DI void attn_core(const u16* __restrict__ Q, int ldq, const u16* __restrict__ Kg, int ldk, const u16* __restrict__ Vg, int ldv, int ntiles, char* smem,
                  f32x4 (&o)[DV / 16][NQT], float (&lsum)[NQT]) {
  constexpr int CK = DQK / 8, CV = DV / 8, KBY = 64 * CK * 16, STAGE = KBY + 64 * CV * 16;
  constexpr int NKI = CK / 4, NVI = CV / 4;
  static_assert(2 * STAGE <= 65536 && NQT == 2, "cfg");
  const int tid = ltid(), lane = tid & 63, w = tid >> 6, g = lane >> 4, li = lane & 15;
  bf16x8 qf[NQT][DQK / 32];
#pragma unroll
  for (int nt = 0; nt < NQT; ++nt)
#pragma unroll
    for (int ks = 0; ks < DQK / 32; ++ks) qf[nt][ks] = *(const bf16x8*)(Q + (size_t)(w * 16 * NQT + nt * 16 + li) * ldq + ks * 32 + g * 8);
#pragma unroll
  for (int vt = 0; vt < DV / 16; ++vt)
#pragma unroll
    for (int nt = 0; nt < NQT; ++nt) o[vt][nt] = (f32x4){0.f, 0.f, 0.f, 0.f};
#pragma unroll
  for (int nt = 0; nt < NQT; ++nt) lsum[nt] = 0.f;
  f32x4 ol[NQT];
#pragma unroll
  for (int nt = 0; nt < NQT; ++nt) ol[nt] = (f32x4){0.f, 0.f, 0.f, 0.f};
  const bf16x8 ones = {(short)0x3F80, (short)0x3F80, (short)0x3F80, (short)0x3F80, (short)0x3F80, (short)0x3F80, (short)0x3F80, (short)0x3F80};
  int ko0 = 0, ko1 = 0, ko2 = 0, vo0 = 0, vo1 = 0, vo2 = 0, vo3 = 0;
#define KOFF(i_) ([&]() { const int n = (w + 4 * (i_)) * 64 + lane, row = n / CK, pos = n % CK; \
    const int c = (CK == 12) ? ((pos & ~3) | ((pos & 3) ^ ((row >> 2) & 3))) : (pos ^ ((row >> 1) & 7)); return row * ldk + c * 8; }())
#define VOFF(i_) ([&]() { const int n = (w + 4 * (i_)) * 64 + lane, row = n / CV, pos = n % CV; \
    const int c = (CV == 8) ? (pos ^ ((row >> 1) & 7)) : (pos ^ (row & 15)); return row * ldv + c * 8; }())
  ko0 = KOFF(0); ko1 = KOFF(1); if (NKI > 2) ko2 = KOFF(2);
  vo0 = VOFF(0); vo1 = VOFF(1); if (NVI > 2) { vo2 = VOFF(2); vo3 = VOFF(3); }
#undef KOFF
#undef VOFF
#define A_GLDS(t_, st_) do { const u16* kp_ = Kg + (size_t)(t_) * 64 * ldk; const u16* vp_ = Vg + (size_t)(t_) * 64 * ldv; char* sk_ = smem + (st_) * STAGE + w * 1024; \
    __builtin_amdgcn_global_load_lds((const unsigned*)(kp_ + ko0), (unsigned*)(sk_), 16, 0, 0); \
    __builtin_amdgcn_global_load_lds((const unsigned*)(kp_ + ko1), (unsigned*)(sk_ + 4096), 16, 0, 0); \
    if (NKI > 2) __builtin_amdgcn_global_load_lds((const unsigned*)(kp_ + ko2), (unsigned*)(sk_ + 8192), 16, 0, 0); \
    __builtin_amdgcn_global_load_lds((const unsigned*)(vp_ + vo0), (unsigned*)(sk_ + KBY), 16, 0, 0); \
    __builtin_amdgcn_global_load_lds((const unsigned*)(vp_ + vo1), (unsigned*)(sk_ + KBY + 4096), 16, 0, 0); \
    if (NVI > 2) { __builtin_amdgcn_global_load_lds((const unsigned*)(vp_ + vo2), (unsigned*)(sk_ + KBY + 8192), 16, 0, 0); \
                   __builtin_amdgcn_global_load_lds((const unsigned*)(vp_ + vo3), (unsigned*)(sk_ + KBY + 12288), 16, 0, 0); } } while (0)
  const unsigned sbase = (unsigned)(size_t)smem;
  unsigned kb0, kb1;
  if (CK == 12) { kb0 = (unsigned)(li * 192 + ((g ^ ((li >> 2) & 3)) << 4)); kb1 = kb0; }
  else { const int p0 = g ^ ((li >> 1) & 7); kb0 = (unsigned)(li * 128 + (p0 << 4)); kb1 = (unsigned)(li * 128 + ((p0 ^ 4) << 4)); }
  unsigned vb[DV / 16];
  { const int rowl = 4 * g + (li >> 2), b = (li & 3) >> 1, h8 = (li & 3) & 1;
    const int f = (CV == 8) ? ((2 * g + (li >> 3)) & 7) : ((4 * g + (li >> 2)) & 15);
#pragma unroll
    for (int vt = 0; vt < DV / 16; ++vt) vb[vt] = (unsigned)(KBY + rowl * CV * 16 + (((vt * 2 + b) ^ f) << 4) + h8 * 8); }
  RAW_BARRIER();
  A_GLDS(0, 0);
#pragma unroll 1
  for (int t = 0; t < ntiles; ++t) {
    asm volatile("s_waitcnt vmcnt(0)" ::: "memory");
    RAW_BARRIER();
    A_GLDS((t + 1 < ntiles ? t + 1 : t), (t + 1) & 1);
    const unsigned st = sbase + (unsigned)((t & 1) * STAGE);
    bf16x8 kf[DQK / 32][4];
    if constexpr (DQK == 96) {
      const unsigned a0 = st + kb0;
      asm volatile(
        "ds_read_b128 %0, %12 offset:0\n\t"
        "ds_read_b128 %1, %12 offset:3072\n\t"
        "ds_read_b128 %2, %12 offset:6144\n\t"
        "ds_read_b128 %3, %12 offset:9216\n\t"
        "ds_read_b128 %4, %12 offset:64\n\t"
        "ds_read_b128 %5, %12 offset:3136\n\t"
        "ds_read_b128 %6, %12 offset:6208\n\t"
        "ds_read_b128 %7, %12 offset:9280\n\t"
        "ds_read_b128 %8, %12 offset:128\n\t"
        "ds_read_b128 %9, %12 offset:3200\n\t"
        "ds_read_b128 %10, %12 offset:6272\n\t"
        "ds_read_b128 %11, %12 offset:9344\n\t"
        "s_waitcnt lgkmcnt(0)"
        : "=&v"(kf[0][0]), "=&v"(kf[0][1]), "=&v"(kf[0][2]), "=&v"(kf[0][3]), "=&v"(kf[1][0]), "=&v"(kf[1][1]), "=&v"(kf[1][2]), "=&v"(kf[1][3]), "=&v"(kf[2][0]), "=&v"(kf[2][1]), "=&v"(kf[2][2]), "=&v"(kf[2][3])
        : "v"(a0) : "memory");
    } else {
      const unsigned a0 = st + kb0, a1 = st + kb1;
      asm volatile(
        "ds_read_b128 %0, %8 offset:0\n\t"
        "ds_read_b128 %1, %8 offset:2048\n\t"
        "ds_read_b128 %2, %8 offset:4096\n\t"
        "ds_read_b128 %3, %8 offset:6144\n\t"
        "ds_read_b128 %4, %9 offset:0\n\t"
        "ds_read_b128 %5, %9 offset:2048\n\t"
        "ds_read_b128 %6, %9 offset:4096\n\t"
        "ds_read_b128 %7, %9 offset:6144\n\t"
        "s_waitcnt lgkmcnt(0)"
        : "=&v"(kf[0][0]), "=&v"(kf[0][1]), "=&v"(kf[0][2]), "=&v"(kf[0][3]), "=&v"(kf[1][0]), "=&v"(kf[1][1]), "=&v"(kf[1][2]), "=&v"(kf[1][3])
        : "v"(a0), "v"(a1) : "memory");
    }
    f32x4 s[4][NQT];
#pragma unroll
    for (int mt = 0; mt < 4; ++mt)
#pragma unroll
      for (int nt = 0; nt < NQT; ++nt) s[mt][nt] = (f32x4){0.f, 0.f, 0.f, 0.f};
#pragma unroll
    for (int ks = 0; ks < DQK / 32; ++ks)
#pragma unroll
      for (int mt = 0; mt < 4; ++mt)
#pragma unroll
        for (int nt = 0; nt < NQT; ++nt) s[mt][nt] = mfma16(kf[ks][mt], qf[nt][ks], s[mt][nt]);
    s16x4 va[DV / 16][2], vc[DV / 16][2];
    unsigned va_[DV / 16];
#pragma unroll
    for (int vt = 0; vt < DV / 16; ++vt) va_[vt] = st + vb[vt];
    if constexpr (DV == 64) {
      asm volatile(
        "ds_read_b64_tr_b16 %0, %8 offset:0\n\t"
        "ds_read_b64_tr_b16 %1, %8 offset:2048\n\t"
        "ds_read_b64_tr_b16 %2, %9 offset:0\n\t"
        "ds_read_b64_tr_b16 %3, %9 offset:2048\n\t"
        "ds_read_b64_tr_b16 %4, %10 offset:0\n\t"
        "ds_read_b64_tr_b16 %5, %10 offset:2048\n\t"
        "ds_read_b64_tr_b16 %6, %11 offset:0\n\t"
        "ds_read_b64_tr_b16 %7, %11 offset:2048"
        : "=&v"(va[0][0]), "=&v"(va[0][1]), "=&v"(va[1][0]), "=&v"(va[1][1]), "=&v"(va[2][0]), "=&v"(va[2][1]), "=&v"(va[3][0]), "=&v"(va[3][1])
        : "v"(va_[0]), "v"(va_[1]), "v"(va_[2]), "v"(va_[3]) : "memory");
    } else {
      asm volatile(
        "ds_read_b64_tr_b16 %0, %16 offset:0\n\t"
        "ds_read_b64_tr_b16 %1, %16 offset:4096\n\t"
        "ds_read_b64_tr_b16 %2, %17 offset:0\n\t"
        "ds_read_b64_tr_b16 %3, %17 offset:4096\n\t"
        "ds_read_b64_tr_b16 %4, %18 offset:0\n\t"
        "ds_read_b64_tr_b16 %5, %18 offset:4096\n\t"
        "ds_read_b64_tr_b16 %6, %19 offset:0\n\t"
        "ds_read_b64_tr_b16 %7, %19 offset:4096\n\t"
        "ds_read_b64_tr_b16 %8, %20 offset:0\n\t"
        "ds_read_b64_tr_b16 %9, %20 offset:4096\n\t"
        "ds_read_b64_tr_b16 %10, %21 offset:0\n\t"
        "ds_read_b64_tr_b16 %11, %21 offset:4096\n\t"
        "ds_read_b64_tr_b16 %12, %22 offset:0\n\t"
        "ds_read_b64_tr_b16 %13, %22 offset:4096\n\t"
        "ds_read_b64_tr_b16 %14, %23 offset:0\n\t"
        "ds_read_b64_tr_b16 %15, %23 offset:4096"
        : "=&v"(va[0][0]), "=&v"(va[0][1]), "=&v"(va[1][0]), "=&v"(va[1][1]), "=&v"(va[2][0]), "=&v"(va[2][1]), "=&v"(va[3][0]), "=&v"(va[3][1]), "=&v"(va[4][0]), "=&v"(va[4][1]), "=&v"(va[5][0]), "=&v"(va[5][1]), "=&v"(va[6][0]), "=&v"(va[6][1]), "=&v"(va[7][0]), "=&v"(va[7][1])
        : "v"(va_[0]), "v"(va_[1]), "v"(va_[2]), "v"(va_[3]), "v"(va_[4]), "v"(va_[5]), "v"(va_[6]), "v"(va_[7]) : "memory");
    }
#pragma unroll
    for (int mt = 0; mt < 4; ++mt)
#pragma unroll
      for (int nt = 0; nt < NQT; ++nt)
#pragma unroll
        for (int jj = 0; jj < 4; ++jj) { const float e = __builtin_amdgcn_exp2f(s[mt][nt][jj]); s[mt][nt][jj] = e; if constexpr (DV != 64) lsum[nt] += e; }
    bf16x8 pf0[NQT], pf1[NQT];
#pragma unroll
    for (int nt = 0; nt < NQT; ++nt) {
      uint4 u; u.x = pack2(s[0][nt][0], s[0][nt][1]); u.y = pack2(s[0][nt][2], s[0][nt][3]); u.z = pack2(s[1][nt][0], s[1][nt][1]); u.w = pack2(s[1][nt][2], s[1][nt][3]);
      pf0[nt] = __builtin_bit_cast(bf16x8, u);
      uint4 v; v.x = pack2(s[2][nt][0], s[2][nt][1]); v.y = pack2(s[2][nt][2], s[2][nt][3]); v.z = pack2(s[3][nt][0], s[3][nt][1]); v.w = pack2(s[3][nt][2], s[3][nt][3]);
      pf1[nt] = __builtin_bit_cast(bf16x8, v);
    }
    if constexpr (DV == 64) {
      asm volatile("s_waitcnt lgkmcnt(0)" : "+v"(va[0][0]), "+v"(va[0][1]), "+v"(va[1][0]), "+v"(va[1][1]), "+v"(va[2][0]), "+v"(va[2][1]), "+v"(va[3][0]), "+v"(va[3][1]) :: "memory");
      asm volatile(
        "ds_read_b64_tr_b16 %0, %8 offset:4096\n\t"
        "ds_read_b64_tr_b16 %1, %8 offset:6144\n\t"
        "ds_read_b64_tr_b16 %2, %9 offset:4096\n\t"
        "ds_read_b64_tr_b16 %3, %9 offset:6144\n\t"
        "ds_read_b64_tr_b16 %4, %10 offset:4096\n\t"
        "ds_read_b64_tr_b16 %5, %10 offset:6144\n\t"
        "ds_read_b64_tr_b16 %6, %11 offset:4096\n\t"
        "ds_read_b64_tr_b16 %7, %11 offset:6144"
        : "=&v"(vc[0][0]), "=&v"(vc[0][1]), "=&v"(vc[1][0]), "=&v"(vc[1][1]), "=&v"(vc[2][0]), "=&v"(vc[2][1]), "=&v"(vc[3][0]), "=&v"(vc[3][1])
        : "v"(va_[0]), "v"(va_[1]), "v"(va_[2]), "v"(va_[3]) : "memory");
    } else {
      asm volatile("s_waitcnt lgkmcnt(0)" : "+v"(va[0][0]), "+v"(va[0][1]), "+v"(va[1][0]), "+v"(va[1][1]), "+v"(va[2][0]), "+v"(va[2][1]), "+v"(va[3][0]), "+v"(va[3][1]), "+v"(va[4][0]), "+v"(va[4][1]), "+v"(va[5][0]), "+v"(va[5][1]), "+v"(va[6][0]), "+v"(va[6][1]), "+v"(va[7][0]), "+v"(va[7][1]) :: "memory");
    }
#pragma unroll
    for (int vt = 0; vt < DV / 16; ++vt) {
      const bf16x8 vf = __builtin_shufflevector(va[vt][0], va[vt][1], 0, 1, 2, 3, 4, 5, 6, 7);
#pragma unroll
      for (int nt = 0; nt < NQT; ++nt) o[vt][nt] = mfma16(vf, pf0[nt], o[vt][nt]);
    }
    if constexpr (DV == 64) {
#pragma unroll
      for (int nt = 0; nt < NQT; ++nt) ol[nt] = mfma16(ones, pf0[nt], ol[nt]);
    }
    if constexpr (DV == 64) { asm volatile("s_waitcnt lgkmcnt(0)" : "+v"(vc[0][0]), "+v"(vc[0][1]), "+v"(vc[1][0]), "+v"(vc[1][1]), "+v"(vc[2][0]), "+v"(vc[2][1]), "+v"(vc[3][0]), "+v"(vc[3][1]), "+v"(o[0][0]) :: "memory"); }
    else {
      asm volatile(
        "ds_read_b64_tr_b16 %0, %16 offset:8192\n\t"
        "ds_read_b64_tr_b16 %1, %16 offset:12288\n\t"
        "ds_read_b64_tr_b16 %2, %17 offset:8192\n\t"
        "ds_read_b64_tr_b16 %3, %17 offset:12288\n\t"
        "ds_read_b64_tr_b16 %4, %18 offset:8192\n\t"
        "ds_read_b64_tr_b16 %5, %18 offset:12288\n\t"
        "ds_read_b64_tr_b16 %6, %19 offset:8192\n\t"
        "ds_read_b64_tr_b16 %7, %19 offset:12288\n\t"
        "ds_read_b64_tr_b16 %8, %20 offset:8192\n\t"
        "ds_read_b64_tr_b16 %9, %20 offset:12288\n\t"
        "ds_read_b64_tr_b16 %10, %21 offset:8192\n\t"
        "ds_read_b64_tr_b16 %11, %21 offset:12288\n\t"
        "ds_read_b64_tr_b16 %12, %22 offset:8192\n\t"
        "ds_read_b64_tr_b16 %13, %22 offset:12288\n\t"
        "ds_read_b64_tr_b16 %14, %23 offset:8192\n\t"
        "ds_read_b64_tr_b16 %15, %23 offset:12288\n\t"
        "s_waitcnt lgkmcnt(0)"
        : "=&v"(vc[0][0]), "=&v"(vc[0][1]), "=&v"(vc[1][0]), "=&v"(vc[1][1]), "=&v"(vc[2][0]), "=&v"(vc[2][1]), "=&v"(vc[3][0]), "=&v"(vc[3][1]), "=&v"(vc[4][0]), "=&v"(vc[4][1]), "=&v"(vc[5][0]), "=&v"(vc[5][1]), "=&v"(vc[6][0]), "=&v"(vc[6][1]), "=&v"(vc[7][0]), "=&v"(vc[7][1])
        : "v"(va_[0]), "v"(va_[1]), "v"(va_[2]), "v"(va_[3]), "v"(va_[4]), "v"(va_[5]), "v"(va_[6]), "v"(va_[7]), "v"(o[DV / 16 - 1][NQT - 1]) : "memory");
    }
#pragma unroll
    for (int vt = 0; vt < DV / 16; ++vt) {
      const bf16x8 vf = __builtin_shufflevector(vc[vt][0], vc[vt][1], 0, 1, 2, 3, 4, 5, 6, 7);
#pragma unroll
      for (int nt = 0; nt < NQT; ++nt) o[vt][nt] = mfma16(vf, pf1[nt], o[vt][nt]);
    }
    if constexpr (DV == 64) {
#pragma unroll
      for (int nt = 0; nt < NQT; ++nt) ol[nt] = mfma16(ones, pf1[nt], ol[nt]);
    }
  }
  asm volatile("s_waitcnt vmcnt(0)" ::: "memory");
  RAW_BARRIER();
#undef A_GLDS
#pragma unroll
  for (int nt = 0; nt < NQT; ++nt) { if constexpr (DV == 64) lsum[nt] = ol[nt][0]; else { float v = lsum[nt]; v += __shfl_xor(v, 16); v += __shfl_xor(v, 32); lsum[nt] = v; } }
}

#ifndef NQTM
#define NQTM 2
#endif
#ifndef NQTD
#define NQTD 2
#endif
constexpr int NQT_M = NQTM, NQT_D = NQTD;
DI void mla_item(const Params& p, int sq, int h, int qb, char* smem) {
  constexpr int QR = 64 * NQT_M;
  const int lane = ltid() & 63, w = ltid() >> 6;
  const int row0 = (sq < 4 ? sq * 256 : 1024) + qb * QR;
  const int key0 = sq < 4 ? sq * 256 : 1024;
  const int ntiles = sq < 4 ? 4 : 68;
  f32x4 o[4][NQT_M]; float ls[NQT_M];
  attn_core<96, 64, NQT_M>((const u16*)(p.ws + B_QB) + (size_t)row0 * 768 + h * 96, 768, (const u16*)(p.ws + B_KB) + (size_t)key0 * 768 + h * 96, 768,
                           (const u16*)(p.ws + B_KVR) + (size_t)key0 * 1024 + 512 + h * 64, 1024, ntiles, smem, o, ls);
  u16* Y = (u16*)(p.ws + B_Y);
#pragma unroll
  for (int nt = 0; nt < NQT_M; ++nt) {
    const float inv = 1.f / ls[nt];
    const int row = row0 + w * 16 * NQT_M + nt * 16 + (lane & 15);
#pragma unroll
    for (int vt = 0; vt < 4; ++vt) {
      uint2 u; u.x = pack2(o[vt][nt][0] * inv, o[vt][nt][1] * inv); u.y = pack2(o[vt][nt][2] * inv, o[vt][nt][3] * inv);
      *(uint2*)(Y + (size_t)row * 1536 + 512 + h * 64 + vt * 16 + (lane >> 4) * 4) = u;
    }
  }
}
DI void diff_item(const Params& p, int sq, int h, int comp, int qb, char* smem) {
  constexpr int QR = 64 * NQT_D;
  const int lane = ltid() & 63, w = ltid() >> 6;
  const int row0 = (sq < 4 ? sq * 256 : 1024) + qb * QR;
  const int key0 = sq < 4 ? sq * 256 : 1024;
  const int ntiles = sq < 4 ? 4 : 68;
  const u16* QC = (const u16*)(p.ws + B_QC); const u16* KC = (const u16*)(p.ws + B_KC); const u16* VC = (const u16*)(p.ws + B_VC);
  f32x4 o[8][NQT_D]; float ls[NQT_D];
  attn_core<64, 128, NQT_D>(QC + (size_t)row0 * 512 + (h * 2 + comp) * 64, 512, KC + (size_t)key0 * 512 + (h * 2 + comp) * 64, 512, VC + (size_t)key0 * 512 + h * 128, 512, ntiles, smem, o, ls);
  u16* T = (u16*)(p.ws + B_T);
#pragma unroll
  for (int nt = 0; nt < NQT_D; ++nt) {
    const float inv = 1.f / ls[nt];
    const int row = row0 + w * 16 * NQT_D + nt * 16 + (lane & 15);
#pragma unroll
    for (int vt = 0; vt < 8; ++vt) {
      uint2 u; u.x = pack2(o[vt][nt][0] * inv, o[vt][nt][1] * inv); u.y = pack2(o[vt][nt][2] * inv, o[vt][nt][3] * inv);
      *(uint2*)(T + ((size_t)row * 2 + comp) * 512 + h * 128 + vt * 16 + (lane >> 4) * 4) = u;
    }
  }
}
DI void phaseF2(const Params& p, int l, int j) {
  const int tid = ltid();
  const float lam = TAB_LAM(p.ws)[l];
  const float post = 1.f - (l == 0 ? 0.2f : 0.35550906759096926f);
  const float* gs = p.in[27] + l * 128;
  for (int it = blockIdx.x; it < TJ * 16 / 256; it += gridDim.x) {
    const int u = it * 256 + tid, r = u >> 4, h = (u >> 2) & 3, qd = u & 3;
    const uint4* s1 = (const uint4*)((const u16*)(p.ws + B_T) + ((size_t)r * 2) * 512 + h * 128 + qd * 32);
    const uint4* s2 = (const uint4*)((const u16*)(p.ws + B_T) + ((size_t)r * 2 + 1) * 512 + h * 128 + qd * 32);
    float x[32]; float ss = 0.f;
#pragma unroll
    for (int i = 0; i < 4; ++i) {
      const uint4 a = s1[i], b = s2[i];
      float xa[8], xb[8]; unpack8(a, xa); unpack8(b, xb);
#pragma unroll
      for (int e = 0; e < 8; ++e) { const float v = xa[e] - lam * xb[e]; x[i * 8 + e] = v; ss += v * v; }
    }
    ss += __shfl_xor(ss, 1); ss += __shfl_xor(ss, 2);
    const float rstd = rsqrtf(ss * (1.f / 128.f) + EPS) * post;
    uint4* dst = (uint4*)((u16*)(p.ws + B_Y) + (size_t)r * 1536 + 1024 + h * 128 + qd * 32);
#pragma unroll
    for (int i = 0; i < 4; ++i) {
      float y[8];
#pragma unroll
      for (int e = 0; e < 8; ++e) y[e] = x[i * 8 + e] * rstd * gs[qd * 32 + i * 8 + e];
      dst[i] = pack8(y);
    }
  }
}
#ifndef FMASK
#define FMASK 31
#endif
DI void phaseF(const Params& p, int l, int j, char* smem, int kmask = 7) {
  constexpr int QBM = 4096 / (64 * NQT_M), QBD = 4096 / (64 * NQT_D), CBM = 256 / (64 * NQT_M), CBD = 256 / (64 * NQT_D);
  const int nDL = 8 * QBD, nML = 8 * QBM, nG3 = 0, nMC = 4 * 8 * CBM, nDC = 4 * 8 * CBD;
  for (int it = blockIdx.x; it < nDL + nML + nG3 + nMC + nDC; it += gridDim.x) {
    int q = it, kind, sq = 4, h = 0, qb = 0;
    if (q < nDL) { kind = 0; h = q % 8; qb = q / 8; }
    else if ((q -= nDL) < nML) { kind = 1; h = q % 8; qb = q / 8; }
    else if ((q -= nML) < nG3) { kind = 2; }
    else if ((q -= nG3) < nMC) { kind = 1; sq = q / (8 * CBM); h = (q / CBM) % 8; qb = q % CBM; }
    else { q -= nMC; kind = 0; sq = q / (8 * CBD); h = (q / CBD) % 8; qb = q % CBD; }
    if (!((kmask >> kind) & 1)) continue;
    if (kind == 0) diff_item(p, sq, h >> 1, h & 1, qb, smem);
    else if (kind == 1) mla_item(p, sq, h, qb, smem);
    else gla_g3_item(p, l, q >> 2, q & 3, smem);
  }
}

DI void phaseG(const Params& p, int l, int j, char* smem) {
  const u16* Y = (const u16*)(p.ws + B_Y); const u16* P = (const u16*)(p.ws + B_P); u16* Mg = (u16*)(p.ws + B_H);
  for (int it = blockIdx.x; it < 64 * 8; it += gridDim.x) {
    const int mt = it % 64, nt = it / 64;
    const int lane = ltid() & 63, wid = ltid() >> 6;
    const int col = nt * 128 + wid * 32 + (lane >> 4) * 8;
    f32x4 tot[5][2]; zero_acc80(tot);
    for (int br = 0; br < 3; ++br) {
      f32x4 acc[5][2]; zero_acc80(acc);
      gemm80_glds(Y + (size_t)mt * 80 * 1536 + br * 512, 1536, (const u16*)(p.ws + W_O) + (size_t)(l * 3 + br) * 1024 * 512 + (size_t)nt * 128 * 512, 512, 512, smem, acc);
#pragma unroll
      for (int mi = 0; mi < 5; ++mi) {
        const int row = mt * 80 + mi * 16 + (lane & 15);
        const uint4 gv = *(const uint4*)(P + (size_t)row * INP + cGT + br * 1024 + col);
        float g[8]; unpack8(gv, g);
#pragma unroll
        for (int e = 0; e < 4; ++e) { tot[mi][0][e] += sigmoidf_(g[e]) * acc[mi][0][e]; tot[mi][1][e] += sigmoidf_(g[4 + e]) * acc[mi][1][e]; }
      }
    }
#pragma unroll
    for (int mi = 0; mi < 5; ++mi) {
      const int row = mt * 80 + mi * 16 + (lane & 15);
      uint4 o; o.x = pack2(tot[mi][0][0], tot[mi][0][1]); o.y = pack2(tot[mi][0][2], tot[mi][0][3]); o.z = pack2(tot[mi][1][0], tot[mi][1][1]); o.w = pack2(tot[mi][1][2], tot[mi][1][3]);
      *(uint4*)(Mg + (size_t)row * 1024 + col) = o;
    }
  }
}
DI void phase_resid(const Params& p, int l, int j, int which, char* smem, bool dry = false) {
  const u16* A = which ? (const u16*)(p.ws + B_P) : (const u16*)(p.ws + B_H);
  const int K = which ? 4096 : 1024;
  const u16* W = which ? (const u16*)(p.ws + W_2) + (size_t)l * 1024 * 4096 : (const u16*)(p.ws + W_OUT) + (size_t)l * 1024 * 1024;
  for (int it = blockIdx.x; it < 64 * 8; it += gridDim.x) {
    const int mt = it % 64, nt = it / 64;
    f32x4 acc[5][2]; zero_acc80(acc);
    gemm80_glds(A + (size_t)mt * 80 * K, K, W + (size_t)nt * 128 * K, K, K, smem, acc);
    epi80_foreach(acc, [&](int row, int col, f32x4 v) {
      const Tok t = tokinfo(j, mt * 80 + row);
      const int c = nt * 128 + col;
      const float* xs = (l == 0 && which == 0) ? (t.g < 4096 ? p.in[0] + (size_t)t.g * 1024 : p.in[1] + (size_t)(t.g - 4096) * 1024) : p.out + (size_t)t.g * 1024;
      const float4 x4 = *(const float4*)(xs + c);
      const float4 g4 = *(const float4*)((const float*)(p.ws + B_MOD) + (l * 5 + t.cond) * 6144 + (which ? 5 : 2) * 1024 + c);
      float4 y; y.x = x4.x + g4.x * v[0]; y.y = x4.y + g4.y * v[1]; y.z = x4.z + g4.z * v[2]; y.w = x4.w + g4.w * v[3];
      if (!dry || v[0] == 12345.678f) *(float4*)(p.out + (size_t)t.g * 1024 + c) = y;
    });
  }
}
DI void phaseB(const Params& p, int l, int j, char* smem) {
  for (int it = blockIdx.x; it < 40 * NT_B; it += gridDim.x) inproj_tile(p, l, it % 40, it / 40, smem);
}
DI void phaseJ(const Params& p, int l, int j, char* smem) {
  u16* Hd = (u16*)(p.ws + B_P);
  for (int it = blockIdx.x; it < 40 * 32; it += gridDim.x) {
    const int mt = it % 40, nt = it / 40;
    f32x4 acc[4][4]; zero_acc(acc);
    gemm_accum_glds((const u16*)(p.ws + B_H) + (size_t)mt * 128 * 1024, 1024, (const u16*)(p.ws + W_1) + (size_t)l * 4096 * 1024 + (size_t)nt * 128 * 1024, 1024, 1024, smem, acc);
    epi_foreach8(acc, [&](int row, int col, f32x4 v, f32x4 w) {
      const float r0 = fmaxf(v[0], 0.f), r1 = fmaxf(v[1], 0.f), r2 = fmaxf(v[2], 0.f), r3 = fmaxf(v[3], 0.f);
      const float r4 = fmaxf(w[0], 0.f), r5 = fmaxf(w[1], 0.f), r6 = fmaxf(w[2], 0.f), r7 = fmaxf(w[3], 0.f);
      uint4 o; o.x = pack2(r0 * r0, r1 * r1); o.y = pack2(r2 * r2, r3 * r3); o.z = pack2(r4 * r4, r5 * r5); o.w = pack2(r6 * r6, r7 * r7);
      *(uint4*)(Hd + (size_t)(mt * 128 + row) * 4096 + nt * 128 + col) = o; });
  }
  if (l == 0 && defer_l1()) {
    const int per = (XT_PER_LAYER + NJ - 1) / NJ, lo = j * per, hi = (lo + per < XT_PER_LAYER) ? lo + per : XT_PER_LAYER;
    if ((int)blockIdx.x >= 256)
      for (int q = lo + ((int)blockIdx.x - 256); q < hi; q += (int)gridDim.x - 256) xpose_item(p, 1, q, smem);
  }
}

#ifndef PHMASK0
#define PHMASK0 1
#endif
DI void run_phase(const Params& p, int id, char* smem) {
  if (id == 0) { if (PHMASK0) phase0(p, smem); return; }
  int nl = -1, nj = 0, nw = 0, rw = -1, l = 0, j = 0;
  if (id == 1) { nl = 0; }
  else {
    const int q = id - 2, ph = q % NPH, lj = q / NPH;
    j = lj % NJ; l = lj / NJ;
    switch (ph) {
      case 0: phaseB(p, l, j, smem); break;
      case 1: phaseC(p, l, j, smem); break;
      case 2: phaseD(p, l, j, smem); break;
      case 3: phaseE(p, l, j, smem); break;
      case 4: phaseF(p, l, j, smem); break;
      case 5: phaseF2(p, l, j); break;
      case 6: phaseG(p, l, j, smem); break;
      case 7: rw = 0; break;
      case 8: nl = l; nj = j; nw = 1; break;
      case 9: phaseJ(p, l, j, smem); break;
      default:
        rw = 1;
        if (lj + 1 < DEPTH * NJ) { nl = (lj + 1) / NJ; nj = (lj + 1) % NJ; nw = 0; }
        break;
    }
  }
  if (rw >= 0) phase_resid(p, l, j, rw, smem);
  if (nl >= 0) ph_normmod(p, nl, nj, nw);
}
constexpr int N_PHASES = 2 + DEPTH * NJ * NPH;

#define XB_TMO      128
#define XB_XCNT(j)  (256  + 64 * (j))
#define XB_XSUB(j)  (1280 + 64 * (j))
#define XB_XGEN(j)  (2304 + 64 * (j))
#define XB_TOP      3328
#define XB_TOPGEN   3392
#define XCD_BAR_WORDS 3456
#define XB_SPIN_CAP (1u << 20)
DI unsigned xb_ld(unsigned* p) { return __hip_atomic_load(p, __ATOMIC_RELAXED, __HIP_MEMORY_SCOPE_AGENT); }
DI unsigned xb_add(unsigned* p, unsigned v) { return __hip_atomic_fetch_add(p, v, __ATOMIC_RELAXED, __HIP_MEMORY_SCOPE_AGENT); }
DI unsigned xb_xcc_id() { return (unsigned)__builtin_amdgcn_s_getreg((3 << 11) | 20) & 0xFu; }
#define XB_SPIN(cond, bar) do { unsigned _sp = 0; while (cond) { __builtin_amdgcn_s_sleep(1); \
    if ((++_sp & 255u) == 0u) { if (xb_ld(&(bar)[XB_TMO])) break; if (_sp > XB_SPIN_CAP) { atomicAdd(&(bar)[XB_TMO], 1u); break; } } } } while (0)
DI void xcd_barrier_complete(unsigned* bar, unsigned x, unsigned& nloc, unsigned& nx) {
  const unsigned G = gridDim.x;
  unsigned sum, cnt, mine, sp = 0u;
  for (;;) {
    sum = 0u; cnt = 0u; mine = 0u;
#pragma unroll
    for (unsigned j = 0; j < 16; ++j) { const unsigned c = xb_ld(&bar[XB_XCNT(j)]); sum += c; cnt += (c > 0u) ? 1u : 0u; mine = (j == x) ? c : mine; }
    if (sum == G) break;
    __builtin_amdgcn_s_sleep(1);
    if ((++sp & 255u) == 0u) { if (xb_ld(&bar[XB_TMO])) break; if (sp > XB_SPIN_CAP) { atomicAdd(&bar[XB_TMO], 1u); break; } }
  }
  nloc = mine > 0u ? mine : 1u; nx = cnt > 0u ? cnt : 1u;
}
DI void xcd_barrier(unsigned* bar, unsigned x, volatile unsigned* st) {
  asm volatile("s_waitcnt vmcnt(0)" ::: "memory");
  __syncthreads();
  if (ltid() == 0) {
    __builtin_amdgcn_s_waitcnt(0);
    unsigned nloc = st[0], nx = st[1];
    if (nloc == 0u) { xcd_barrier_complete(bar, x, nloc, nx); st[0] = nloc; st[1] = nx; }
    const unsigned old = xb_add(&bar[XB_XSUB(x)], 1u);
    const unsigned gen = old / nloc;
    if (old + 1u == (gen + 1u) * nloc) {
      __builtin_amdgcn_fence(__ATOMIC_RELEASE, "agent");
      asm volatile("s_waitcnt vmcnt(0)" ::: "memory");
      const unsigned og = xb_add(&bar[XB_TOP], 1u);
      const unsigned tg = og / nx;
      if (og + 1u == (tg + 1u) * nx) xb_add(&bar[XB_TOPGEN], 1u);
      else XB_SPIN(xb_ld(&bar[XB_TOPGEN]) == tg, bar);
      __builtin_amdgcn_fence(__ATOMIC_ACQUIRE, "agent");
      xb_add(&bar[XB_XGEN(x)], 1u);
      asm volatile("s_waitcnt vmcnt(0)" ::: "memory");
    } else {
      XB_SPIN(xb_ld(&bar[XB_XGEN(x)]) == gen, bar);
      __builtin_amdgcn_fence(__ATOMIC_ACQUIRE, "agent");
      asm volatile("s_waitcnt vmcnt(0)" ::: "memory");
    }
  }
  __syncthreads();
}

__global__ void __launch_bounds__(256, 2) mega(Params p, int ph_lo, int ph_hi) {
  __shared__ __attribute__((aligned(16))) char smem[65536];
#if !MULTI_LAUNCH
  cg::grid_group grid = cg::this_grid();
  __shared__ uint4 xb_words;
  unsigned* bar = (unsigned*)(p.ws + WS_END);
  const unsigned xcc = xb_xcc_id();
  if (ltid() == 0) { xb_words = make_uint4(0u, 0u, 0u, 0u); (void)xb_add(&bar[XB_XCNT(xcc)], 1u); }
  __syncthreads();
#endif
  for (int id = ph_lo; id < ph_hi; ++id) {
    run_phase(p, id, smem);
#if !MULTI_LAUNCH
    if (id + 1 < ph_hi) {
      if (id == ph_lo) grid.sync();
      else {
        xcd_barrier(bar, xcc, (volatile unsigned*)&xb_words);
#ifdef DUPBAR
        xcd_barrier(bar, xcc, (volatile unsigned*)&xb_words);
#endif
      }
    }
#endif
  }
}

extern "C" void kernel_launch(void* const* d_in, const int* in_sizes, int n_in, void* d_out, int out_size, void* d_ws, size_t ws_size, hipStream_t stream) {
  static int grid_blocks = 0;
  if (!grid_blocks) {
    int dev = 0, cus = 0, per_cu = 0;
    hipGetDevice(&dev);
    hipDeviceGetAttribute(&cus, hipDeviceAttributeMultiprocessorCount, dev);
    hipOccupancyMaxActiveBlocksPerMultiprocessor(&per_cu, mega, 256, 0);
    if (per_cu < 1) per_cu = 1;
    if (per_cu > 2) per_cu = 2;
    grid_blocks = cus * per_cu;
    if (ws_size < WS_END + XCD_BAR_WORDS * 4) fprintf(stderr, "kernel_launch: workspace too small: %zu < %zu\n", ws_size, (size_t)WS_END);
  }
  Params p{};
  for (int i = 0; i < 34; ++i) p.in[i] = (const float*)d_in[i];
  p.out = (float*)d_out; p.ws = (char*)d_ws;
  (void)hipMemsetAsync((char*)d_ws + WS_END, 0, XCD_BAR_WORDS * 4, stream);
#if MULTI_LAUNCH
  for (int id = 0; id < N_PHASES; ++id) hipLaunchKernelGGL(mega, dim3(grid_blocks), dim3(256), 0, stream, p, id, id + 1);
#else
  int lo = 0, hi = N_PHASES;
  void* args[] = {&p, &lo, &hi};
  hipError_t e = hipLaunchCooperativeKernel((void*)mega, dim3(grid_blocks), dim3(256), args, 0, stream);
  if (e != hipSuccess) fprintf(stderr, "cooperative launch failed: %s (grid %d)\n", hipGetErrorString(e), grid_blocks);
#endif
}
```

```cpp
#include <hip/hip_runtime.h>
#include <hip/hip_cooperative_groups.h>
#include <cstdio>
#include <cstdint>
namespace cg = cooperative_groups;

#ifndef MULTI_LAUNCH
#define MULTI_LAUNCH 0
#endif

typedef unsigned short u16;
typedef __attribute__((ext_vector_type(8))) short bf16x8;
typedef __attribute__((ext_vector_type(4))) short s16x4;
typedef __attribute__((ext_vector_type(4))) float f32x4;
#define DI __device__ __forceinline__
#define LDSP(T, p) ((__attribute__((address_space(3))) T*)(p))

constexpr int D = 1024, DEPTH = 2;
constexpr int INC = 6848, INP = 6912;
constexpr int cAQ = 0, cAK = 256, cAV = 512, cAR = 1024, cAA = 1536, cQD = 1568, cKVD = 1952, cKR = 2208, cDQ = 2240, cDK = 2752, cDV = 3264, cGT = 3776;
constexpr int NJ = 4, TJ = 5120, KRJ = 5376, NCH = 80;
constexpr int NPH = 11;
constexpr float EPS = 1e-6f;
constexpr float LOG2E = 1.4426950408889634f;
constexpr float QS_M = 0.10206207261596575f * LOG2E;
constexpr float QS_D = 0.125f * LOG2E;

constexpr size_t O_GLA = 20971520, O_CKV = 23068672, O_KR = 25165824, O_DK = 25427968, O_DV = 29622272;

constexpr size_t al(size_t x) { return (x + 255) & ~(size_t)255; }
constexpr size_t W_IN = 0;
constexpr size_t W_UQ = W_IN + al((size_t)2 * INP * 1024 * 2);
constexpr size_t W_UKV = W_UQ + al((size_t)2 * 768 * 384 * 2);
constexpr size_t W_O = W_UKV + al((size_t)2 * 1024 * 256 * 2);
constexpr size_t W_OUT = W_O + al((size_t)6 * 1024 * 512 * 2);
constexpr size_t W_1 = W_OUT + al((size_t)2 * 1024 * 1024 * 2);
constexpr size_t W_2 = W_1 + al((size_t)2 * 4096 * 1024 * 2);
constexpr size_t B_MOD = W_2 + al((size_t)2 * 4096 * 1024 * 2);
constexpr size_t B_TAB = B_MOD + al((size_t)2 * 5 * 6144 * 4);
constexpr size_t B_H = B_TAB + al(16384);
constexpr size_t B_P = B_H + al((size_t)TJ * 1024 * 2);
constexpr size_t B_QB = B_P + al((size_t)TJ * INP * 2);
constexpr size_t B_CKV = B_QB + al((size_t)TJ * 768 * 2);
constexpr size_t B_KRB = B_CKV + al((size_t)KRJ * 256 * 2);
constexpr size_t B_KVR = B_KRB + al((size_t)KRJ * 32 * 2);
constexpr size_t B_KB = B_KVR + al((size_t)KRJ * 1024 * 2);
constexpr size_t B_KC = B_KB + al((size_t)KRJ * 768 * 2);
constexpr size_t B_VC = B_KC + al((size_t)KRJ * 512 * 2);
constexpr size_t B_U = B_VC + al((size_t)KRJ * 512 * 2);
constexpr size_t B_DEC = B_U + al((size_t)NCH * 8 * 8192 * 2);
constexpr size_t B_Y = B_DEC + al((size_t)NCH * 8 * 64 * 4);
constexpr size_t B_QC = B_Y + al((size_t)TJ * 1536 * 2);
constexpr size_t B_UP = B_QC + al((size_t)TJ * 512 * 2);
constexpr size_t B_RQ = B_UP + al((size_t)NCH * 8 * 8192 * 2);
constexpr size_t B_T = B_RQ + al((size_t)TJ * 4);
constexpr size_t WS_END = B_T + al((size_t)TJ * 1024 * 2);

struct Params {
  const float* in[34];
  float* out;
  char* ws;
};

DI int ltid() { int t = threadIdx.x; asm volatile("" : "+v"(t)); return t; }
DI float bf2f(u16 v) { return __uint_as_float(((unsigned)v) << 16); }
typedef __bf16 bf16v2 __attribute__((ext_vector_type(2)));
typedef float f32v2 __attribute__((ext_vector_type(2)));
DI unsigned pack2(float a, float b) { f32v2 v = {a, b}; return __builtin_bit_cast(unsigned, __builtin_convertvector(v, bf16v2)); }
DI u16 f2bf(float x) { return (u16)(pack2(x, 0.f) & 0xffffu); }
DI float wave_sum(float v) {
#pragma unroll
  for (int o = 32; o > 0; o >>= 1) v += __shfl_xor(v, o);
  return v;
}
DI float sigmoidf_(float x) { return 1.0f / (1.0f + __expf(-x)); }
DI f32x4 mfma16(bf16x8 a, bf16x8 b, f32x4 c) { return __builtin_amdgcn_mfma_f32_16x16x32_bf16(a, b, c, 0, 0, 0); }
DI s16x4 trr(const char* p) { return __builtin_amdgcn_ds_read_tr16_b64_v4i16(LDSP(s16x4, p)); }
DI bf16x8 tr_frag(const char* img, int stride, int k0, int n0, int lane) {
  const int g = lane >> 4, i = lane & 15;
  const char* p = img + (k0 + 8 * g + (i >> 2)) * stride + (n0 + 4 * (i & 3)) * 2;
  s16x4 lo = trr(p), hi = trr(p + 4 * stride);
  return __builtin_shufflevector(lo, hi, 0, 1, 2, 3, 4, 5, 6, 7);
}

struct Tok { int g, cond, b, s; bool lat; };
DI Tok tokinfo(int j, int r) {
  Tok t;
  if (r < 1024) { t.g = j * 1024 + r; t.cond = 0; t.b = t.g >> 8; t.s = t.g & 255; t.lat = false; }
  else { t.s = r - 1024; t.g = 4096 + j * 4096 + t.s; t.cond = 1 + j; t.b = j; t.lat = true; }
  return t;
}
DI int keyrow(int r) { return r < 1024 ? r : r + 256; }

DI void g_load(uint4 (&ra)[4], uint4 (&rb)[4], const u16* __restrict__ ga, const u16* __restrict__ gb, int lda, int ldb, int k0) {
#pragma unroll
  for (int i = 0; i < 4; ++i) { ra[i] = *(const uint4*)(ga + (size_t)i * 32 * lda + k0); rb[i] = *(const uint4*)(gb + (size_t)i * 32 * ldb + k0); }
}
DI void g_store(const uint4 (&ra)[4], const uint4 (&rb)[4], char* d, int soff) {
#pragma unroll
  for (int i = 0; i < 4; ++i) { *(uint4*)(d + soff + i * 4096) = ra[i]; *(uint4*)(d + 16384 + soff + i * 4096) = rb[i]; }
}
DI void g_compute(const char* sa, f32x4 (&acc)[4][4], int lane, int wm, int wn) {
  const char* sb = sa + 16384;
#pragma unroll
  for (int kk = 0; kk < 2; ++kk) {
    bf16x8 af[4], bfr[4];
    const int ch = kk * 4 + (lane >> 4);
#pragma unroll
    for (int mi = 0; mi < 4; ++mi) { const int row = wm * 64 + mi * 16 + (lane & 15); af[mi] = *(const bf16x8*)(sa + row * 128 + ((ch ^ (row & 7)) << 4)); }
#pragma unroll
    for (int ni = 0; ni < 4; ++ni) { const int row = wn * 64 + ni * 16 + (lane & 15); bfr[ni] = *(const bf16x8*)(sb + row * 128 + ((ch ^ (row & 7)) << 4)); }
#pragma unroll
    for (int mi = 0; mi < 4; ++mi)
#pragma unroll
      for (int ni = 0; ni < 4; ++ni) acc[mi][ni] = mfma16(bfr[ni], af[mi], acc[mi][ni]);
  }
}
template <bool DEEP = true>
DI void gemm_accum(const u16* __restrict__ A, int lda, const u16* __restrict__ Bt, int ldb, int K, char* smem, f32x4 (&acc)[4][4]) {
  const int tid = ltid(), lane = tid & 63, wid = tid >> 6, wm = wid >> 1, wn = wid & 1;
  const int srow = tid >> 3, skc = tid & 7;
  const int soff = srow * 128 + ((skc ^ (srow & 7)) << 4);
  const u16* ga = A + (size_t)srow * lda + skc * 8;
  const u16* gb = Bt + (size_t)srow * ldb + skc * 8;
  const int nk = K >> 6;
  const int klast = (nk - 1) << 6;
  if (DEEP) {
    uint4 p0, p1, p2, p3, p4, p5, p6, p7, q0, q1, q2, q3, q4, q5, q6, q7;
#define GL(a0, a1, a2, a3, b0, b1, b2, b3, k0_) do { const int kk_ = (k0_); \
      a0 = *(const uint4*)(ga + kk_); a1 = *(const uint4*)(ga + (size_t)32 * lda + kk_); a2 = *(const uint4*)(ga + (size_t)64 * lda + kk_); a3 = *(const uint4*)(ga + (size_t)96 * lda + kk_); \
      b0 = *(const uint4*)(gb + kk_); b1 = *(const uint4*)(gb + (size_t)32 * ldb + kk_); b2 = *(const uint4*)(gb + (size_t)64 * ldb + kk_); b3 = *(const uint4*)(gb + (size_t)96 * ldb + kk_); } while (0)
#define GS(a0, a1, a2, a3, b0, b1, b2, b3, d_) do { char* dd_ = (d_) + soff; \
      *(uint4*)(dd_) = a0; *(uint4*)(dd_ + 4096) = a1; *(uint4*)(dd_ + 8192) = a2; *(uint4*)(dd_ + 12288) = a3; \
      *(uint4*)(dd_ + 16384) = b0; *(uint4*)(dd_ + 20480) = b1; *(uint4*)(dd_ + 24576) = b2; *(uint4*)(dd_ + 28672) = b3; } while (0)
    GL(p0, p1, p2, p3, p4, p5, p6, p7, 0);
    GL(q0, q1, q2, q3, q4, q5, q6, q7, 64);
    GS(p0, p1, p2, p3, p4, p5, p6, p7, smem);
    __syncthreads();
#pragma unroll 1
    for (int kt = 0; kt < nk; kt += 2) {
      GL(p0, p1, p2, p3, p4, p5, p6, p7, min((kt + 2) << 6, klast));
      g_compute(smem, acc, lane, wm, wn);
      GS(q0, q1, q2, q3, q4, q5, q6, q7, smem + 32768);
      __syncthreads();
      GL(q0, q1, q2, q3, q4, q5, q6, q7, min((kt + 3) << 6, klast));
      g_compute(smem + 32768, acc, lane, wm, wn);
      GS(p0, p1, p2, p3, p4, p5, p6, p7, smem);
      __syncthreads();
    }
#undef GL
#undef GS
  } else {
    uint4 ra0[4], rb0[4];
    g_load(ra0, rb0, ga, gb, lda, ldb, 0);
    g_store(ra0, rb0, smem, soff);
    __syncthreads();
#pragma unroll 1
    for (int kt = 0; kt < nk; kt += 2) {
      g_load(ra0, rb0, ga, gb, lda, ldb, (kt + 1) << 6);
      g_compute(smem, acc, lane, wm, wn);
      g_store(ra0, rb0, smem + 32768, soff);
      __syncthreads();
      g_load(ra0, rb0, ga, gb, lda, ldb, min((kt + 2) << 6, klast));
      g_compute(smem + 32768, acc, lane, wm, wn);
      g_store(ra0, rb0, smem, soff);
      __syncthreads();
    }
  }
}
#define RAW_BARRIER() do { asm volatile("s_waitcnt lgkmcnt(0)" ::: "memory"); __builtin_amdgcn_s_barrier(); asm volatile("" ::: "memory"); } while (0)
DI void gemm_accum_glds(const u16* __restrict__ A, int lda, const u16* __restrict__ Bt, int ldb, int K, char* smem, f32x4 (&acc)[4][4]) {
  const int tid = ltid(), lane = tid & 63, wid = tid >> 6, wm = wid >> 1, wn = wid & 1;
  const int prow = lane >> 3, pkc = (lane & 7) ^ prow;
  const u16* ga = A + (size_t)(wid * 32 + prow) * lda + pkc * 8;
  const u16* gb = Bt + (size_t)(wid * 32 + 8 * (prow >> 2) + (prow & 3)) * ldb + pkc * 8;
  const int nk = K >> 6;
  const int klast = (nk - 1) << 6;
  const int fq = lane >> 4, fr = lane & 15;
  const unsigned sbase = (unsigned)(size_t)smem;
  const unsigned f0 = (unsigned)(fr * 128 + ((fq ^ (fr & 7)) << 4)), f1 = (unsigned)(fr * 128 + (((fq ^ (fr & 7)) ^ 4) << 4));
#define GLDS_TILE(k0_, st_) do { char* sb_ = smem + (st_) * 32768 + wid * 4096; const int kk_ = (k0_); \
    __builtin_amdgcn_global_load_lds((const unsigned*)(ga + kk_), (unsigned*)(sb_), 16, 0, 0); \
    __builtin_amdgcn_global_load_lds((const unsigned*)(ga + (size_t)8 * lda + kk_), (unsigned*)(sb_ + 1024), 16, 0, 0); \
    __builtin_amdgcn_global_load_lds((const unsigned*)(ga + (size_t)16 * lda + kk_), (unsigned*)(sb_ + 2048), 16, 0, 0); \
    __builtin_amdgcn_global_load_lds((const unsigned*)(ga + (size_t)24 * lda + kk_), (unsigned*)(sb_ + 3072), 16, 0, 0); \
    __builtin_amdgcn_global_load_lds((const unsigned*)(gb + kk_), (unsigned*)(sb_ + 16384), 16, 0, 0); \
    __builtin_amdgcn_global_load_lds((const unsigned*)(gb + (size_t)16 * ldb + kk_), (unsigned*)(sb_ + 16384 + 1024), 16, 0, 0); \
    __builtin_amdgcn_global_load_lds((const unsigned*)(gb + (size_t)4 * ldb + kk_), (unsigned*)(sb_ + 16384 + 2048), 16, 0, 0); \
    __builtin_amdgcn_global_load_lds((const unsigned*)(gb + (size_t)20 * ldb + kk_), (unsigned*)(sb_ + 16384 + 3072), 16, 0, 0); } while (0)
  RAW_BARRIER();
  GLDS_TILE(0, 0);
#pragma unroll 1
  for (int kt = 0; kt < nk; ++kt) {
    asm volatile("s_waitcnt vmcnt(0)" ::: "memory");
    RAW_BARRIER();
    GLDS_TILE(min((kt + 1) << 6, klast), (kt + 1) & 1);
    const unsigned st = sbase + (unsigned)((kt & 1) * 32768);
    const unsigned a0 = st + (unsigned)(wm * 8192) + f0, a1 = st + (unsigned)(wm * 8192) + f1;
    const unsigned b0 = st + 16384u + (unsigned)(wn * 8192) + f0, b1 = st + 16384u + (unsigned)(wn * 8192) + f1;
    bf16x8 af[4], bfr[4], ag[4], bg[4];
    asm volatile(
        "ds_read_b128 %0, %16\n\t"
        "ds_read_b128 %1, %16 offset:2048\n\t"
        "ds_read_b128 %2, %16 offset:4096\n\t"
        "ds_read_b128 %3, %16 offset:6144\n\t"
        "ds_read_b128 %4, %17\n\t"
        "ds_read_b128 %5, %17 offset:2048\n\t"
        "ds_read_b128 %6, %17 offset:4096\n\t"
        "ds_read_b128 %7, %17 offset:6144\n\t"
        "ds_read_b128 %8, %18\n\t"
        "ds_read_b128 %9, %18 offset:2048\n\t"
        "ds_read_b128 %10, %18 offset:4096\n\t"
        "ds_read_b128 %11, %18 offset:6144\n\t"
        "ds_read_b128 %12, %19\n\t"
        "ds_read_b128 %13, %19 offset:2048\n\t"
        "ds_read_b128 %14, %19 offset:4096\n\t"
        "ds_read_b128 %15, %19 offset:6144\n\t"
        "s_waitcnt lgkmcnt(8)"
        : "=&v"(af[0]), "=&v"(af[1]), "=&v"(af[2]), "=&v"(af[3]), "=&v"(bfr[0]), "=&v"(bfr[1]), "=&v"(bfr[2]), "=&v"(bfr[3]),
          "=&v"(ag[0]), "=&v"(ag[1]), "=&v"(ag[2]), "=&v"(ag[3]), "=&v"(bg[0]), "=&v"(bg[1]), "=&v"(bg[2]), "=&v"(bg[3])
        : "v"(a0), "v"(b0), "v"(a1), "v"(b1)
        : "memory");
#pragma unroll
    for (int mi = 0; mi < 4; ++mi)
#pragma unroll
      for (int ni = 0; ni < 4; ++ni) acc[mi][ni] = mfma16(bfr[ni], af[mi], acc[mi][ni]);
    asm volatile("s_waitcnt lgkmcnt(0)" : "+v"(ag[0]), "+v"(ag[1]), "+v"(ag[2]), "+v"(ag[3]), "+v"(bg[0]), "+v"(bg[1]), "+v"(bg[2]), "+v"(bg[3]), "+v"(acc[2][3]) :: "memory");
#pragma unroll
    for (int mi = 0; mi < 4; ++mi)
#pragma unroll
      for (int ni = 0; ni < 4; ++ni) acc[mi][ni] = mfma16(bg[ni], ag[mi], acc[mi][ni]);
  }
  asm volatile("s_waitcnt vmcnt(0)" ::: "memory");
  RAW_BARRIER();
#undef GLDS_TILE
}
DI void gemm80_glds(const u16* __restrict__ A, int lda, const u16* __restrict__ Bt, int ldb, int K, char* smem, f32x4 (&acc)[5][2]) {
  const int tid = ltid(), lane = tid & 63, wid = tid >> 6;
  const int prow = lane >> 3, pkc = (lane & 7) ^ prow;
  const u16* ga = A + (size_t)(wid * 8 + prow) * lda + pkc * 8;
  const u16* gb = Bt + (size_t)(wid * 32 + 8 * (prow >> 2) + (prow & 3)) * ldb + pkc * 8;
  const int nk = K >> 6;
  const int fq = lane >> 4, fr = lane & 15;
  const unsigned sbase = (unsigned)(size_t)smem;
  const unsigned f0 = (unsigned)(fr * 128 + ((fq ^ (fr & 7)) << 4)), f1 = (unsigned)(fr * 128 + (((fq ^ (fr & 7)) ^ 4) << 4));
#define GLDS80(k0_, st_) do { char* sa_ = smem + (st_) * 32768 + wid * 1024; char* sb_ = smem + (st_) * 32768 + 16384 + wid * 4096; const int kk_ = (k0_); \
    __builtin_amdgcn_global_load_lds((const unsigned*)(ga + kk_), (unsigned*)(sa_), 16, 0, 0); \
    __builtin_amdgcn_global_load_lds((const unsigned*)(ga + (size_t)32 * lda + kk_), (unsigned*)(sa_ + 4096), 16, 0, 0); \
    if (wid < 2) __builtin_amdgcn_global_load_lds((const unsigned*)(ga + (size_t)64 * lda + kk_), (unsigned*)(sa_ + 8192), 16, 0, 0); \
    __builtin_amdgcn_global_load_lds((const unsigned*)(gb + kk_), (unsigned*)(sb_), 16, 0, 0); \
    __builtin_amdgcn_global_load_lds((const unsigned*)(gb + (size_t)16 * ldb + kk_), (unsigned*)(sb_ + 1024), 16, 0, 0); \
    __builtin_amdgcn_global_load_lds((const unsigned*)(gb + (size_t)4 * ldb + kk_), (unsigned*)(sb_ + 2048), 16, 0, 0); \
    __builtin_amdgcn_global_load_lds((const unsigned*)(gb + (size_t)20 * ldb + kk_), (unsigned*)(sb_ + 3072), 16, 0, 0); } while (0)
  RAW_BARRIER();
  GLDS80(0, 0);
#pragma unroll 1
  for (int kt = 0; kt < nk; ++kt) {
    asm volatile("s_waitcnt vmcnt(0)" ::: "memory");
    RAW_BARRIER();
    if (kt + 1 < nk) GLDS80((kt + 1) << 6, (kt + 1) & 1);
    const unsigned st = sbase + (unsigned)((kt & 1) * 32768);
    const unsigned a0 = st + f0, a1 = st + f1;
    const unsigned b0 = st + 16384u + (unsigned)(wid * 4096) + f0, b1 = st + 16384u + (unsigned)(wid * 4096) + f1;
    bf16x8 af[5], bfr[2], ag[5], bg[2];
    asm volatile(
        "ds_read_b128 %0, %14\n\t"
        "ds_read_b128 %1, %14 offset:2048\n\t"
        "ds_read_b128 %2, %14 offset:4096\n\t"
        "ds_read_b128 %3, %14 offset:6144\n\t"
        "ds_read_b128 %4, %14 offset:8192\n\t"
        "ds_read_b128 %5, %15\n\t"
        "ds_read_b128 %6, %15 offset:2048\n\t"
        "ds_read_b128 %7, %16\n\t"
        "ds_read_b128 %8, %16 offset:2048\n\t"
        "ds_read_b128 %9, %16 offset:4096\n\t"
        "ds_read_b128 %10, %16 offset:6144\n\t"
        "ds_read_b128 %11, %16 offset:8192\n\t"
        "ds_read_b128 %12, %17\n\t"
        "ds_read_b128 %13, %17 offset:2048\n\t"
        "s_waitcnt lgkmcnt(7)"
        : "=&v"(af[0]), "=&v"(af[1]), "=&v"(af[2]), "=&v"(af[3]), "=&v"(af[4]), "=&v"(bfr[0]), "=&v"(bfr[1]),
          "=&v"(ag[0]), "=&v"(ag[1]), "=&v"(ag[2]), "=&v"(ag[3]), "=&v"(ag[4]), "=&v"(bg[0]), "=&v"(bg[1])
        : "v"(a0), "v"(b0), "v"(a1), "v"(b1)
        : "memory");
#pragma unroll
    for (int mi = 0; mi < 5; ++mi)
#pragma unroll
      for (int ni = 0; ni < 2; ++ni) acc[mi][ni] = mfma16(bfr[ni], af[mi], acc[mi][ni]);
    asm volatile("s_waitcnt lgkmcnt(0)" : "+v"(ag[0]), "+v"(ag[1]), "+v"(ag[2]), "+v"(ag[3]), "+v"(ag[4]), "+v"(bg[0]), "+v"(bg[1]), "+v"(acc[3][1]) :: "memory");
#pragma unroll
    for (int mi = 0; mi < 5; ++mi)
#pragma unroll
      for (int ni = 0; ni < 2; ++ni) acc[mi][ni] = mfma16(bg[ni], ag[mi], acc[mi][ni]);
  }
  RAW_BARRIER();
#undef GLDS80
}
template <class F>
DI void epi80_foreach(const f32x4 (&acc)[5][2], F f) {
  const int lane = ltid() & 63, wid = ltid() >> 6;
#pragma unroll
  for (int mi = 0; mi < 5; ++mi)
#pragma unroll
    for (int ni = 0; ni < 2; ++ni) f(mi * 16 + (lane & 15), wid * 32 + (lane >> 4) * 8 + ni * 4, acc[mi][ni]);
}
DI void zero_acc80(f32x4 (&acc)[5][2]) {
#pragma unroll
  for (int mi = 0; mi < 5; ++mi)
#pragma unroll
    for (int ni = 0; ni < 2; ++ni) acc[mi][ni] = (f32x4){0.f, 0.f, 0.f, 0.f};
}
template <class F>
DI void epi_foreach(const f32x4 (&acc)[4][4], F f) {
  const int lane = ltid() & 63, wid = ltid() >> 6, wm = wid >> 1, wn = wid & 1;
#pragma unroll
  for (int mi = 0; mi < 4; ++mi)
#pragma unroll
    for (int ni = 0; ni < 4; ++ni) f(wm * 64 + mi * 16 + (lane & 15), wn * 64 + (ni >> 1) * 32 + (lane >> 4) * 8 + (ni & 1) * 4, acc[mi][ni]);
}
template <class F>
DI void epi_foreach8(const f32x4 (&acc)[4][4], F f) {
  const int lane = ltid() & 63, wid = ltid() >> 6, wm = wid >> 1, wn = wid & 1;
#pragma unroll
  for (int mi = 0; mi < 4; ++mi)
#pragma unroll
    for (int np = 0; np < 2; ++np) f(wm * 64 + mi * 16 + (lane & 15), wn * 64 + np * 32 + (lane >> 4) * 8, acc[mi][2 * np], acc[mi][2 * np + 1]);
}
DI void zero_acc(f32x4 (&acc)[4][4]) {
#pragma unroll
  for (int mi = 0; mi < 4; ++mi)
#pragma unroll
    for (int ni = 0; ni < 4; ++ni) acc[mi][ni] = (f32x4){0.f, 0.f, 0.f, 0.f};
}

DI void xpose_tile(const float* __restrict__ src, int N, int K, u16* __restrict__ dst, int k0, int n0, float* tile, const float* __restrict__ ksc) {
  const int tid = ltid();
  { const int n4 = (tid & 15) * 4, kr = tid >> 4;
    float4 v[4];
#pragma unroll
    for (int i = 0; i < 4; ++i) v[i] = *(const float4*)(src + (size_t)(k0 + i * 16 + kr) * N + n0 + n4);
#pragma unroll
    for (int i = 0; i < 4; ++i) {
      const int k = i * 16 + kr;
      const float sc = ksc ? ksc[k0 + k] : 1.f;
      float* t = tile + k * 65 + n4;
      t[0] = v[i].x * sc; t[1] = v[i].y * sc; t[2] = v[i].z * sc; t[3] = v[i].w * sc;
    } }
  __syncthreads();
  { const int k8 = (tid & 7) * 8, nn = tid >> 3;
#pragma unroll
    for (int i = 0; i < 2; ++i) {
      const int n = i * 32 + nn;
      float x[8];
#pragma unroll
      for (int e = 0; e < 8; ++e) x[e] = tile[(k8 + e) * 65 + n];
      uint4 o; o.x = pack2(x[0], x[1]); o.y = pack2(x[2], x[3]); o.z = pack2(x[4], x[5]); o.w = pack2(x[6], x[7]);
      *(uint4*)(dst + (size_t)(n0 + n) * K + k0 + k8) = o;
    } }
  __syncthreads();
}
constexpr int XT_PER_LAYER = 4536;
DI void xpose_item(const Params& p, int l, int r, char* smem) {
  char* ws = p.ws;
  const float* src; u16* dst; int K, N; const float* ksc = nullptr;
  if (r < 1712) { src = p.in[13] + (size_t)l * 1024 * INC; K = 1024; N = INC; dst = (u16*)(ws + W_IN) + (size_t)l * INP * 1024; }
  else if ((r -= 1712) < 72) { src = p.in[19] + (size_t)l * 384 * 768; K = 384; N = 768; dst = (u16*)(ws + W_UQ) + (size_t)l * 768 * 384; ksc = p.in[17] + l * 384; }
  else if ((r -= 72) < 32) { src = p.in[20] + (size_t)l * 256 * 512; K = 256; N = 512; dst = (u16*)(ws + W_UKV) + (size_t)l * 1024 * 256; }
  else if ((r -= 32) < 32) { src = p.in[21] + (size_t)l * 256 * 512; K = 256; N = 512; dst = (u16*)(ws + W_UKV) + (size_t)l * 1024 * 256 + 512 * 256; }
  else if ((r -= 32) < 128) { src = p.in[28] + (size_t)l * 512 * 1024; K = 512; N = 1024; dst = (u16*)(ws + W_O) + (size_t)(l * 3 + 0) * 1024 * 512; }
  else if ((r -= 128) < 128) { src = p.in[29] + (size_t)l * 512 * 1024; K = 512; N = 1024; dst = (u16*)(ws + W_O) + (size_t)(l * 3 + 1) * 1024 * 512; }
  else if ((r -= 128) < 128) { src = p.in[30] + (size_t)l * 512 * 1024; K = 512; N = 1024; dst = (u16*)(ws + W_O) + (size_t)(l * 3 + 2) * 1024 * 512; }
  else if ((r -= 128) < 256) { src = p.in[31] + (size_t)l * 1024 * 1024; K = 1024; N = 1024; dst = (u16*)(ws + W_OUT) + (size_t)l * 1024 * 1024; }
  else if ((r -= 256) < 1024) { src = p.in[32] + (size_t)l * 1024 * 4096; K = 1024; N = 4096; dst = (u16*)(ws + W_1) + (size_t)l * 4096 * 1024; }
  else { r -= 1024; src = p.in[33] + (size_t)l * 4096 * 1024; K = 4096; N = 1024; dst = (u16*)(ws + W_2) + (size_t)l * 1024 * 4096; }
  const int nkt = K >> 6;
  xpose_tile(src, N, K, dst, (r % nkt) * 64, (r / nkt) * 64, (float*)smem, ksc);
}
DI bool defer_l1() { return gridDim.x >= 512; }
DI void phase0(const Params& p, char* smem) {
  const int tid = ltid();
  char* ws = p.ws;
  const int n_mod = 192, n_x = (defer_l1() ? 1 : 2) * XT_PER_LAYER, n_items = n_mod + n_x + 1 + 2;
  for (int it0 = blockIdx.x; it0 < n_items; it0 += gridDim.x) {
    if (it0 < n_mod) {
      const int l = it0 / 96, n0 = (it0 % 96) * 64;
      float* sc = (float*)smem;
      float* red = sc + 5 * 1024;
      __syncthreads();
      for (int i = tid; i < 5 * 1024; i += 256) { const int c = i >> 10, k = i & 1023; const float x = c == 0 ? p.in[8][k] : p.in[7][(c - 1) * 1024 + k]; sc[i] = x * sigmoidf_(x); }
      __syncthreads();
      const int c4 = (tid & 15) * 4, kg = tid >> 4;
      float4 a0 = make_float4(0.f, 0.f, 0.f, 0.f), a1 = a0, a2 = a0, a3 = a0, a4 = a0;
      const float* w = p.in[9] + (size_t)l * 1024 * 6144 + n0 + c4;
#pragma unroll 8
      for (int k = kg * 64; k < kg * 64 + 64; ++k) {
        const float4 wv = *(const float4*)(w + (size_t)k * 6144);
        const float s0 = sc[k], s1 = sc[1024 + k], s2 = sc[2048 + k], s3 = sc[3072 + k], s4 = sc[4096 + k];
        a0.x += s0 * wv.x; a0.y += s0 * wv.y; a0.z += s0 * wv.z; a0.w += s0 * wv.w;
        a1.x += s1 * wv.x; a1.y += s1 * wv.y; a1.z += s1 * wv.z; a1.w += s1 * wv.w;
        a2.x += s2 * wv.x; a2.y += s2 * wv.y; a2.z += s2 * wv.z; a2.w += s2 * wv.w;
        a3.x += s3 * wv.x; a3.y += s3 * wv.y; a3.z += s3 * wv.z; a3.w += s3 * wv.w;
        a4.x += s4 * wv.x; a4.y += s4 * wv.y; a4.z += s4 * wv.z; a4.w += s4 * wv.w;
      }
      *(float4*)(red + (kg * 5 + 0) * 64 + c4) = a0; *(float4*)(red + (kg * 5 + 1) * 64 + c4) = a1; *(float4*)(red + (kg * 5 + 2) * 64 + c4) = a2;
      *(float4*)(red + (kg * 5 + 3) * 64 + c4) = a3; *(float4*)(red + (kg * 5 + 4) * 64 + c4) = a4;
      __syncthreads();
      for (int i = tid; i < 320; i += 256) {
        const int c = i >> 6, nn = i & 63;
        float sum = p.in[10][l * 6144 + n0 + nn];
#pragma unroll
        for (int g = 0; g < 16; ++g) sum += red[(g * 5 + c) * 64 + nn];
        ((float*)(ws + B_MOD))[(l * 5 + c) * 6144 + n0 + nn] = sum;
      }
      __syncthreads();
      continue;
    }
    const int it = it0 - n_mod;
    if (it < n_x) {
      xpose_item(p, it / XT_PER_LAYER, it % XT_PER_LAYER, smem);
    } else if (it == n_x) {
      float* tab = (float*)(ws + B_TAB);
      if (tid < 2) {
        const float* lq = p.in[26] + tid * 256;
        float s1 = 0.f, s2 = 0.f;
        for (int i = 0; i < 64; ++i) { s1 += lq[i] * lq[64 + i]; s2 += lq[128 + i] * lq[192 + i]; }
        const float lam_init = tid == 0 ? 0.2f : 0.35550906759096926f;
        tab[tid] = __expf(s1) - __expf(s2) + lam_init;
      }
      for (int i = tid; i < 64 * 8; i += 256) { const int pos = i >> 3, f = i & 7; const float inv = exp2f(-(float)f * (13.287712379549449f / 8.f)); const float a = (float)pos * inv; tab[16 + i * 2] = __cosf(a); tab[16 + i * 2 + 1] = __sinf(a); }
      for (int i = tid; i < 64 * 16; i += 256) { const int pos = i >> 4, f = i & 15; const float inv = exp2f(-(float)f * (13.287712379549449f / 16.f)); const float a = (float)pos * inv; tab[16 + 1024 + i * 2] = __cosf(a); tab[16 + 1024 + i * 2 + 1] = __sinf(a); }
    } else {
      const int l = it - (n_x + 1);
      uint4* z = (uint4*)((u16*)(ws + W_IN) + (size_t)l * INP * 1024 + (size_t)INC * 1024);
      for (int i = tid; i < 64 * 1024 * 2 / 16; i += 256) z[i] = make_uint4(0, 0, 0, 0);
    }
  }
}
#define TAB_LAM(ws) ((const float*)((ws) + B_TAB))
#define TAB_CSM(ws) ((const float*)((ws) + B_TAB) + 16)
#define TAB_CSD(ws) ((const float*)((ws) + B_TAB) + 16 + 1024)

DI void ph_normmod(const Params& p, int l, int j, int which) {
  const int wave = ltid() >> 6, lane = ltid() & 63;
  const float* gn = p.in[which ? 12 : 11] + l * 1024;
  u16* H = (u16*)(p.ws + B_H);
  const int step = (int)gridDim.x * 4;
  for (int rb = blockIdx.x * 4 + wave; rb < TJ; rb += 3 * step) {
    float4 v[3][4];
#pragma unroll
    for (int q = 0; q < 3; ++q) {
      const int r = rb + q * step;
      if (r < TJ) {
        const Tok t = tokinfo(j, r);
        const float* x = (l == 0 && which == 0) ? (t.g < 4096 ? p.in[0] + (size_t)t.g * 1024 : p.in[1] + (size_t)(t.g - 4096) * 1024) : p.out + (size_t)t.g * 1024;
#pragma unroll
        for (int i = 0; i < 4; ++i) v[q][i] = *(const float4*)(x + (i >> 1) * 512 + lane * 8 + (i & 1) * 4);
      }
    }
#pragma unroll
    for (int q = 0; q < 3; ++q) {
      const int r = rb + q * step;
      if (r < TJ) {
        const Tok t = tokinfo(j, r);
        const float* md = (const float*)(p.ws + B_MOD) + (l * 5 + t.cond) * 6144;
        const float* sh = md + (which ? 3 : 0) * 1024;
        const float* sc = md + (which ? 4 : 1) * 1024;
        float ss = 0.f;
#pragma unroll
        for (int i = 0; i < 4; ++i) ss += v[q][i].x * v[q][i].x + v[q][i].y * v[q][i].y + v[q][i].z * v[q][i].z + v[q][i].w * v[q][i].w;
        ss = wave_sum(ss);
        const float rstd = rsqrtf(ss * (1.f / 1024.f) + EPS);
#pragma unroll
        for (int i2 = 0; i2 < 2; ++i2) {
          const int col = i2 * 512 + lane * 8;
          float y[8];
#pragma unroll
          for (int hlf = 0; hlf < 2; ++hlf) {
            const float4 g4 = *(const float4*)(gn + col + hlf * 4), s4 = *(const float4*)(sc + col + hlf * 4), h4 = *(const float4*)(sh + col + hlf * 4);
            const float4 vv = v[q][i2 * 2 + hlf];
            y[hlf * 4 + 0] = vv.x * rstd * g4.x * (1.f + s4.x) + h4.x; y[hlf * 4 + 1] = vv.y * rstd * g4.y * (1.f + s4.y) + h4.y;
            y[hlf * 4 + 2] = vv.z * rstd * g4.z * (1.f + s4.z) + h4.z; y[hlf * 4 + 3] = vv.w * rstd * g4.w * (1.f + s4.w) + h4.w;
          }
          uint4 o; o.x = pack2(y[0], y[1]); o.y = pack2(y[2], y[3]); o.z = pack2(y[4], y[5]); o.w = pack2(y[6], y[7]);
          *(uint4*)(H + (size_t)r * 1024 + col) = o;
        }
      }
    }
  }
}

constexpr int G_BS = 0;
constexpr int G_QT = 16640;
constexpr int G_AS = 17664;
constexpr int G_QP = 25856;
constexpr int G_KP = 35072;
constexpr int G_VS = 44288;
DI float logsig(float x) { return fminf(x, 0.f) - __logf(1.f + __expf(-fabsf(x))); }

DI void gla_stage(const Params& p, const u16* P, int row0, int h, char* smem) {
  const int tid = ltid();
  float* aS = (float*)(smem + G_AS);
#pragma unroll
  for (int i = 0; i < 8; ++i) { const int e = tid + i * 256, t = e >> 5, c = e & 31; aS[e] = bf2f(P[(size_t)(row0 + t) * INP + cAA + c]); }
#pragma unroll
  for (int i = 0; i < 4; ++i) { const int c = tid + i * 256, row = c >> 4, ch = c & 15; *(uint4*)(smem + G_VS + row * 272 + ch * 16) = *(const uint4*)(P + (size_t)(row0 + row) * INP + cAV + h * 128 + ch * 8); }
  __syncthreads();
}
DI void gla_load_w(const Params& p, int l, int h, int dir, float (&wa)[16], float& bias) {
  const int d = ltid() & 63;
  const float* w = p.in[14] + (size_t)((l * 2 + dir) * 16) * 256 + h * 64 + d;
#pragma unroll
  for (int r = 0; r < 16; ++r) wa[r] = w[r * 256];
  bias = p.in[15][(l * 2 + dir) * 256 + h * 64 + d];
}
DI void gla_cum(int dir, char* smem, const float (&wa0)[16], const float (&wa1)[16], float b0, float b1) {
  const int tid = ltid(), d = tid & 63, tq = tid >> 6;
  float* bS = (float*)(smem + G_BS); float* qt = (float*)(smem + G_QT); const float* aS = (const float*)(smem + G_AS);
  float wa[16];
#pragma unroll
  for (int r = 0; r < 16; ++r) wa[r] = dir ? wa1[r] : wa0[r];
  const float bias = dir ? b1 : b0;
  float run = 0.f;
#pragma unroll
  for (int ii = 0; ii < 16; ++ii) {
    const int t = tq * 16 + (dir ? 15 - ii : ii);
    float lg = bias;
#pragma unroll
    for (int r = 0; r < 16; ++r) lg += aS[t * 32 + dir * 16 + r] * wa[r];
    run += logsig(lg) * (1.f / 16.f);
    bS[t * 65 + d] = run;
  }
  qt[tq * 64 + d] = run;
  __syncthreads();
  float off = 0.f;
#pragma unroll
  for (int q = 0; q < 4; ++q) { const bool take = dir ? (q > tq) : (q < tq); off += take ? qt[q * 64 + d] : 0.f; }
#pragma unroll
  for (int ii = 0; ii < 16; ++ii) { const int t = tq * 16 + ii; bS[t * 65 + d] += off; }
  __syncthreads();
}

DI void gla_g1_item(const Params& p, int l, int c, int h, char* smem) {
  const int tid = ltid(), lane = tid & 63, w = tid >> 6, d = tid & 63, tq = tid >> 6;
  const u16* P = (const u16*)(p.ws + B_P);
  const int row0 = c * 64;
  float kreg[16];
#pragma unroll
  for (int ii = 0; ii < 16; ++ii) kreg[ii] = bf2f(P[(size_t)(row0 + tq * 16 + ii) * INP + cAK + h * 64 + d]);
  float wa0[16], wa1[16], wb0, wb1;
  gla_load_w(p, l, h, 0, wa0, wb0); gla_load_w(p, l, h, 1, wa1, wb1);
  gla_stage(p, P, row0, h, smem);
  const float* bS = (const float*)(smem + G_BS);
  for (int dir = 0; dir < 2; ++dir) {
    gla_cum(dir, smem, wa0, wa1, wb0, wb1);
    const float bend = dir ? bS[d] : bS[63 * 65 + d];
#pragma unroll
    for (int ii = 0; ii < 16; ++ii) {
      const int t = tq * 16 + ii;
      *(u16*)(smem + G_KP + t * 144 + d * 2) = f2bf(kreg[ii] * __expf(bend - bS[t * 65 + d]));
    }
    if (tq == 0) ((float*)(p.ws + B_DEC))[((c * 4 + h) * 2 + dir) * 64 + d] = __expf(bend);
    __syncthreads();
    f32x4 acc[2][4];
#pragma unroll
    for (int a = 0; a < 2; ++a)
#pragma unroll
      for (int b = 0; b < 4; ++b) acc[a][b] = (f32x4){0.f, 0.f, 0.f, 0.f};
#pragma unroll
    for (int ks = 0; ks < 2; ++ks) {
      bf16x8 bfr[4];
#pragma unroll
      for (int nt = 0; nt < 4; ++nt) bfr[nt] = tr_frag(smem + G_KP, 144, ks * 32, nt * 16, lane);
#pragma unroll
      for (int vi = 0; vi < 2; ++vi) {
        const bf16x8 af = tr_frag(smem + G_VS, 272, ks * 32, (2 * w + vi) * 16, lane);
#pragma unroll
        for (int nt = 0; nt < 4; ++nt) acc[vi][nt] = mfma16(af, bfr[nt], acc[vi][nt]);
      }
    }
    u16* U = (u16*)(p.ws + B_U) + (size_t)((c * 4 + h) * 2 + dir) * 8192;
#pragma unroll
    for (int vi = 0; vi < 2; ++vi)
#pragma unroll
      for (int nt = 0; nt < 4; ++nt)
#pragma unroll
        for (int jj = 0; jj < 4; ++jj) U[((2 * w + vi) * 16 + (lane >> 4) * 4 + jj) * 64 + nt * 16 + (lane & 15)] = f2bf(acc[vi][nt][jj]);
    __syncthreads();
  }
}

template <int BT>
DI void g2_scan(const u16* __restrict__ U, u16* __restrict__ UP, const float* __restrict__ DEC, int c_lo, int c_hi, int h, int dir, int d, int e, float& s) {
  const int n = c_hi - c_lo;
  for (int i0 = 0; i0 < n; i0 += BT) {
    float tmp[BT], dc[BT];
#pragma unroll
    for (int k = 0; k < BT; ++k) {
      const int c = dir ? (c_hi - 1 - i0 - k) : (c_lo + i0 + k);
      tmp[k] = bf2f(U[(size_t)((c * 4 + h) * 2 + dir) * 8192 + e]); dc[k] = DEC[((c * 4 + h) * 2 + dir) * 64 + d];
    }
#pragma unroll
    for (int k = 0; k < BT; ++k) {
      const int c = dir ? (c_hi - 1 - i0 - k) : (c_lo + i0 + k);
      UP[(size_t)((c * 4 + h) * 2 + dir) * 8192 + e] = f2bf(s); s = dc[k] * s + tmp[k];
    }
  }
}
DI void gla_g2_item(const Params& p, int l, int j, int q) {
  const int tid = ltid();
  int c_lo, c_hi, hd, e, b; bool lat;
  if (q < 256) { lat = true; hd = q >> 5; e = (q & 31) * 256 + tid; c_lo = 16; c_hi = 80; b = j; }
  else { const int qq = q - 256; lat = false; const int sq = qq >> 8; hd = (qq >> 5) & 7; e = (qq & 31) * 256 + tid; c_lo = sq * 4; c_hi = c_lo + 4; b = j * 4 + sq; }
  const int h = hd >> 1, dir = hd & 1, d = e & 63, v = e >> 6;
  float s = lat ? p.in[2][((size_t)(((b * 2 + l) * 2 + dir) * 4 + h) * 64 + d) * 128 + v] : 0.f;
  const u16* U = (const u16*)(p.ws + B_U); u16* UP = (u16*)(p.ws + B_UP); const float* DEC = (const float*)(p.ws + B_DEC);
  if (lat) g2_scan<32>(U, UP, DEC, c_lo, c_hi, h, dir, d, e, s);
  else g2_scan<4>(U, UP, DEC, c_lo, c_hi, h, dir, d, e, s);
  if (!lat) p.out[O_GLA + ((size_t)(((b * 2 + l) * 2 + dir) * 4 + h) * 64 + d) * 128 + v] = s;
}

DI void gla_g3_item(const Params& p, int l, int c, int h, char* smem) {
  const int tid = ltid(), lane = tid & 63, w = tid >> 6, d = tid & 63, tq = tid >> 6;
  const u16* P = (const u16*)(p.ws + B_P);
  const int row0 = c * 64;
  u16 rreg[4][8];
#pragma unroll
  for (int jj = 0; jj < 4; ++jj)
#pragma unroll
    for (int vt = 0; vt < 8; ++vt) rreg[jj][vt] = P[(size_t)(row0 + 16 * w + (lane >> 4) * 4 + jj) * INP + cAR + h * 128 + vt * 16 + (lane & 15)];
  float qreg[16], kreg[16];
#pragma unroll
  for (int ii = 0; ii < 16; ++ii) {
    qreg[ii] = bf2f(P[(size_t)(row0 + tq * 16 + ii) * INP + cAQ + h * 64 + d]) * 0.125f;
    kreg[ii] = bf2f(P[(size_t)(row0 + tq * 16 + ii) * INP + cAK + h * 64 + d]);
  }
  float wa0[16], wa1[16], wb0, wb1;
  gla_load_w(p, l, h, 0, wa0, wb0); gla_load_w(p, l, h, 1, wa1, wb1);
  gla_stage(p, P, row0, h, smem);
  const float* bS = (const float*)(smem + G_BS);
  f32x4 o[8];
#pragma unroll
  for (int vt = 0; vt < 8; ++vt) o[vt] = (f32x4){0.f, 0.f, 0.f, 0.f};
  for (int dir = 0; dir < 2; ++dir) {
    gla_cum(dir, smem, wa0, wa1, wb0, wb1);
#pragma unroll
    for (int ii = 0; ii < 16; ++ii) {
      const int t = tq * 16 + ii;
      const float bb = bS[t * 65 + d];
      *(u16*)(smem + G_QP + t * 144 + d * 2) = f2bf(qreg[ii] * __expf(bb));
      *(u16*)(smem + G_KP + t * 144 + d * 2) = f2bf(kreg[ii] * __expf(-bb));
    }
    __syncthreads();
    bf16x8 af[2];
#pragma unroll
    for (int ks = 0; ks < 2; ++ks) af[ks] = *(const bf16x8*)(smem + G_QP + (16 * w + (lane & 15)) * 144 + (ks * 32 + (lane >> 4) * 8) * 2);
#pragma unroll
    for (int nt = 0; nt < 4; ++nt) {
      f32x4 sa = (f32x4){0.f, 0.f, 0.f, 0.f};
#pragma unroll
      for (int ks = 0; ks < 2; ++ks) {
        const bf16x8 bk = *(const bf16x8*)(smem + G_KP + (nt * 16 + (lane & 15)) * 144 + (ks * 32 + (lane >> 4) * 8) * 2);
        sa = mfma16(af[ks], bk, sa);
      }
      const int sidx = nt * 16 + (lane & 15);
#pragma unroll
      for (int jj = 0; jj < 4; ++jj) {
        const int t = 16 * w + (lane >> 4) * 4 + jj;
        const bool keep = dir ? (sidx >= t) : (sidx <= t);
        *(u16*)(smem + G_BS + t * 144 + sidx * 2) = keep ? f2bf(sa[jj]) : (u16)0;
      }
    }
    __syncthreads();
    bf16x8 at[2];
#pragma unroll
    for (int ks = 0; ks < 2; ++ks) at[ks] = *(const bf16x8*)(smem + G_BS + (16 * w + (lane & 15)) * 144 + (ks * 32 + (lane >> 4) * 8) * 2);
    const u16* Up = (const u16*)(p.ws + B_UP) + (size_t)((c * 4 + h) * 2 + dir) * 8192;
#pragma unroll
    for (int vt = 0; vt < 8; ++vt) {
#pragma unroll
      for (int ks = 0; ks < 2; ++ks) {
        const bf16x8 bv = tr_frag(smem + G_VS, 272, ks * 32, vt * 16, lane);
        o[vt] = mfma16(at[ks], bv, o[vt]);
        const bf16x8 bs = *(const bf16x8*)(Up + (vt * 16 + (lane & 15)) * 64 + ks * 32 + (lane >> 4) * 8);
        o[vt] = mfma16(af[ks], bs, o[vt]);
      }
    }
    __syncthreads();
  }
  u16* Y = (u16*)(p.ws + B_Y);
  const float* go = p.in[16] + l * 128;
#pragma unroll
  for (int jj = 0; jj < 4; ++jj) {
    float ss = 0.f;
#pragma unroll
    for (int vt = 0; vt < 8; ++vt) ss += o[vt][jj] * o[vt][jj];
    ss += __shfl_xor(ss, 1); ss += __shfl_xor(ss, 2); ss += __shfl_xor(ss, 4); ss += __shfl_xor(ss, 8);
    const float rstd = rsqrtf(ss * (1.f / 128.f) + EPS);
    const int row = row0 + 16 * w + (lane >> 4) * 4 + jj;
#pragma unroll
    for (int vt = 0; vt < 8; ++vt) {
      const int v = vt * 16 + (lane & 15);
      const float r = bf2f(rreg[jj][vt]);
      Y[(size_t)row * 1536 + h * 128 + v] = f2bf(o[vt][jj] * rstd * go[v] * (r * sigmoidf_(r)));
    }
  }
}

DI void unpack8(const uint4 v, float* x) {
  x[0] = __uint_as_float(v.x << 16); x[1] = __uint_as_float(v.x & 0xffff0000u); x[2] = __uint_as_float(v.y << 16); x[3] = __uint_as_float(v.y & 0xffff0000u);
  x[4] = __uint_as_float(v.z << 16); x[5] = __uint_as_float(v.z & 0xffff0000u); x[6] = __uint_as_float(v.w << 16); x[7] = __uint_as_float(v.w & 0xffff0000u);
}
DI uint4 pack8(const float* x) { uint4 v; v.x = pack2(x[0], x[1]); v.y = pack2(x[2], x[3]); v.z = pack2(x[4], x[5]); v.w = pack2(x[6], x[7]); return v; }
DI void tokpost16(const Params& p, int l, int j, int r0) {
  const int tid = ltid();
  const u16* __restrict__ P = (const u16*)(p.ws + B_P);
  {
    const int r = r0 + (tid >> 4), u = tid & 15, grp = u & 7; const bool isk = u >= 8;
    const Tok t = tokinfo(j, r);
    const uint4* src = (const uint4*)(P + (size_t)r * INP + (isk ? cDK : cDQ) + grp * 64);
    uint4 v[8];
#pragma unroll
    for (int i = 0; i < 8; ++i) v[i] = src[i];
    float x[64]; float ss = 0.f;
#pragma unroll
    for (int i = 0; i < 8; ++i) unpack8(v[i], x + i * 8);
#pragma unroll
    for (int e = 0; e < 64; ++e) ss += x[e] * x[e];
    const float rstd = rsqrtf(ss * (1.f / 64.f) + EPS);
    const float* g = p.in[isk ? 25 : 24] + l * 64;
#pragma unroll
    for (int e = 0; e < 64; ++e) x[e] *= rstd * g[e];
    if (isk && !t.lat) {
      float4* o = (float4*)(p.out + O_DK + (size_t)((t.b * 2 + l) * 256 + t.s) * 512 + grp * 64);
#pragma unroll
      for (int i = 0; i < 16; ++i) o[i] = make_float4(x[i * 4], x[i * 4 + 1], x[i * 4 + 2], x[i * 4 + 3]);
    }
    if (t.lat) {
#pragma unroll
      for (int hh = 0; hh < 2; ++hh) {
        const int pos = hh ? (t.s & 63) : (t.s >> 6);
        const float* cs = TAB_CSD(p.ws) + pos * 32;
#pragma unroll
        for (int i = 0; i < 16; ++i) {
          const float a = x[hh * 32 + i], b = x[hh * 32 + 16 + i], c = cs[2 * i], sn = cs[2 * i + 1];
          x[hh * 32 + i] = a * c - b * sn; x[hh * 32 + 16 + i] = a * sn + b * c;
        }
      }
    }
    const float sc = isk ? 1.f : QS_D;
#pragma unroll
    for (int e = 0; e < 64; ++e) x[e] *= sc;
    uint4* dst = isk ? (uint4*)((u16*)(p.ws + B_KC) + (size_t)keyrow(r) * 512 + grp * 64) : (uint4*)((u16*)(p.ws + B_QC) + (size_t)r * 512 + grp * 64);
#pragma unroll
    for (int i = 0; i < 8; ++i) dst[i] = pack8(x + i * 8);
  }
  {
#pragma unroll
    for (int i = 0; i < 4; ++i) {
      const int c = tid + i * 256, r = r0 + (c >> 6), ch = c & 63;
      const Tok t = tokinfo(j, r);
      const uint4 v = *(const uint4*)(P + (size_t)r * INP + cDV + ch * 8);
      *(uint4*)((u16*)(p.ws + B_VC) + (size_t)keyrow(r) * 512 + ch * 8) = v;
      if (!t.lat) { float x[8]; unpack8(v, x); float4* o = (float4*)(p.out + O_DV + (size_t)((t.b * 2 + l) * 256 + t.s) * 512 + ch * 8); o[0] = make_float4(x[0], x[1], x[2], x[3]); o[1] = make_float4(x[4], x[5], x[6], x[7]); }
    }
    if (tid < 64) {
      const int r = r0 + (tid >> 2), ch = tid & 3;
      const Tok t = tokinfo(j, r);
      const uint4 v = *(const uint4*)(P + (size_t)r * INP + cKR + ch * 8);
      *(uint4*)((u16*)(p.ws + B_KRB) + (size_t)keyrow(r) * 32 + ch * 8) = v;
      if (!t.lat) { float x[8]; unpack8(v, x); float4* o = (float4*)(p.out + O_KR + (size_t)((t.b * 2 + l) * 256 + t.s) * 32 + ch * 8); o[0] = make_float4(x[0], x[1], x[2], x[3]); o[1] = make_float4(x[4], x[5], x[6], x[7]); }
    }
  }
  {
    const int r = r0 + (tid >> 4), u = tid & 15;
    const Tok t = tokinfo(j, r);
    const uint4* src = (const uint4*)(P + (size_t)r * INP + cKVD + u * 16);
    const uint4* sq = (const uint4*)(P + (size_t)r * INP + cQD + u * 24);
    const uint4 v0 = src[0], v1 = src[1], q0 = sq[0], q1 = sq[1], q2 = sq[2];
    float x[16], y[24];
    unpack8(v0, x); unpack8(v1, x + 8); unpack8(q0, y); unpack8(q1, y + 8); unpack8(q2, y + 16);
    float ss = 0.f, sq2 = 0.f;
#pragma unroll
    for (int e = 0; e < 16; ++e) ss += x[e] * x[e];
#pragma unroll
    for (int e = 0; e < 24; ++e) sq2 += y[e] * y[e];
    ss += __shfl_xor(ss, 1); ss += __shfl_xor(ss, 2); ss += __shfl_xor(ss, 4); ss += __shfl_xor(ss, 8);
    sq2 += __shfl_xor(sq2, 1); sq2 += __shfl_xor(sq2, 2); sq2 += __shfl_xor(sq2, 4); sq2 += __shfl_xor(sq2, 8);
    const float rstd = rsqrtf(ss * (1.f / 256.f) + EPS);
    const float* g = p.in[18] + l * 256 + u * 16;
#pragma unroll
    for (int e = 0; e < 16; ++e) x[e] *= rstd * g[e];
    uint4* dst = (uint4*)((u16*)(p.ws + B_CKV) + (size_t)keyrow(r) * 256 + u * 16);
    dst[0] = pack8(x); dst[1] = pack8(x + 8);
    if (!t.lat) {
      float4* o = (float4*)(p.out + O_CKV + (size_t)((t.b * 2 + l) * 256 + t.s) * 256 + u * 16);
#pragma unroll
      for (int i = 0; i < 4; ++i) o[i] = make_float4(x[i * 4], x[i * 4 + 1], x[i * 4 + 2], x[i * 4 + 3]);
    }
    if (u == 0) ((float*)(p.ws + B_RQ))[r] = sq2 * (1.f / 384.f);
  }
}
DI void cachepost(const Params& p, int l, int j, int pr, int lane) {
  const size_t rb = (size_t)((j * 2 + l) * 256 + pr);
  const int kr = 1024 + pr;
  u16* ck = (u16*)(p.ws + B_CKV) + (size_t)kr * 256;
#pragma unroll
  for (int i = 0; i < 4; ++i) ck[i * 64 + lane] = f2bf(p.in[3][rb * 256 + i * 64 + lane]);
  if (lane < 32) ((u16*)(p.ws + B_KRB))[(size_t)kr * 32 + lane] = f2bf(p.in[4][rb * 32 + lane]);
  u16* kc = (u16*)(p.ws + B_KC) + (size_t)kr * 512; u16* vc = (u16*)(p.ws + B_VC) + (size_t)kr * 512;
#pragma unroll
  for (int i = 0; i < 8; ++i) { kc[i * 64 + lane] = f2bf(p.in[5][rb * 512 + i * 64 + lane]); vc[i * 64 + lane] = f2bf(p.in[6][rb * 512 + i * 64 + lane]); }
}
DI void phaseC(const Params& p, int l, int j, char* smem) {
  const int wave = ltid() >> 6, lane = ltid() & 63;
  const int nG = NCH * 4, nT = TJ / 16, nC = 16, nQ = 40 * 6;
  const bool split = (int)gridDim.x >= nG + 128;
  const int step = split ? ((int)blockIdx.x < nG ? (1 << 20) : (int)gridDim.x - nG) : (int)gridDim.x;
  for (int it = blockIdx.x; it < nG + nT + nC + nQ; it += step) {
    if (it < nG) gla_g1_item(p, l, it >> 2, it & 3, smem);
    else if (it < nG + nT) tokpost16(p, l, j, (it - nG) * 16);
    else if (it < nG + nT + nC) { const int r0 = (it - nG - nT) * 16 + wave * 4; for (int i = 0; i < 4; ++i) cachepost(p, l, j, r0 + i, lane); }
    else {
      const int q = it - nG - nT - nC, mt = q % 40, nt = q / 40;
      f32x4 acc[4][4]; zero_acc(acc);
      gemm_accum_glds((const u16*)(p.ws + B_P) + (size_t)mt * 128 * INP + cQD, INP, (const u16*)(p.ws + W_UQ) + (size_t)l * 768 * 384 + (size_t)nt * 128 * 384, 384, 384, smem, acc);
      u16* QB = (u16*)(p.ws + B_QB);
      epi_foreach8(acc, [&](int row, int col, f32x4 v, f32x4 w) { uint4 o; o.x = pack2(v[0], v[1]); o.y = pack2(v[2], v[3]); o.z = pack2(w[0], w[1]); o.w = pack2(w[2], w[3]); *(uint4*)(QB + (size_t)(mt * 128 + row) * 768 + nt * 128 + col) = o; });
    }
  }
}

DI void phaseD(const Params& p, int l, int j, char* smem) {
  const int nG2a = 256, nQ = 0, nKV = 42 * 8, nG2b = 1024;
  const int lane = ltid() & 63; (void)lane;
  const int step = (int)gridDim.x;
  for (int it = blockIdx.x; it < nG2a + nQ + nKV + nG2b; it += step) {
    if (it < nG2a) gla_g2_item(p, l, j, it);
    else if (it < nG2a + nQ) {
    } else if (it < nG2a + nQ + nKV) {
      const int q = it - nG2a - nQ, mt = q % 42, nt = q / 42;
      f32x4 acc[4][4]; zero_acc(acc);
      gemm_accum_glds((const u16*)(p.ws + B_CKV) + (size_t)mt * 128 * 256, 256, (const u16*)(p.ws + W_UKV) + (size_t)l * 1024 * 256 + (size_t)nt * 128 * 256, 256, 256, smem, acc);
      u16* KVR = (u16*)(p.ws + B_KVR);
      epi_foreach8(acc, [&](int row, int col, f32x4 v, f32x4 w) { uint4 o; o.x = pack2(v[0], v[1]); o.y = pack2(v[2], v[3]); o.z = pack2(w[0], w[1]); o.w = pack2(w[2], w[3]); *(uint4*)(KVR + (size_t)(mt * 128 + row) * 1024 + nt * 128 + col) = o; });
    } else gla_g2_item(p, l, j, 256 + it - nG2a - nQ - nKV);
  }
}

DI void inproj_tile(const Params& p, int l, int mt, int nt, char* smem) {
  u16* P = (u16*)(p.ws + B_P);
  f32x4 acc[4][4]; zero_acc(acc);
  gemm_accum_glds((const u16*)(p.ws + B_H) + (size_t)mt * 128 * 1024, 1024, (const u16*)(p.ws + W_IN) + (size_t)l * INP * 1024 + (size_t)nt * 128 * 1024, 1024, 1024, smem, acc);
  epi_foreach8(acc, [&](int row, int col, f32x4 v, f32x4 w) { uint4 o; o.x = pack2(v[0], v[1]); o.y = pack2(v[2], v[3]); o.z = pack2(w[0], w[1]); o.w = pack2(w[2], w[3]); *(uint4*)(P + (size_t)(mt * 128 + row) * INP + nt * 128 + col) = o; });
}
constexpr int NT_B = 51;
DI void phaseE(const Params& p, int l, int j, char* smem) {
  const int tid = ltid();
  const int nG3 = NCH * 4, nQ = TJ * 8 / 256, nK = KRJ * 8 / 256;
  const bool split = (int)gridDim.x >= nG3 + 128;
  const int step = split ? ((int)blockIdx.x < nG3 ? (1 << 20) : (int)gridDim.x - nG3) : (int)gridDim.x;
  const int nIn = 40 * (54 - NT_B);
  for (int it0 = blockIdx.x; it0 < nG3 + nIn + nQ + nK; it0 += step) {
    if (it0 < nG3) { gla_g3_item(p, l, it0 >> 2, it0 & 3, smem); continue; }
    if (it0 < nG3 + nIn) { const int q = it0 - nG3; inproj_tile(p, l, q % 40, NT_B + q / 40, smem); continue; }
    const int it = it0 - nG3 - nIn;
    const bool isq = it < nQ;
    const int u = (isq ? it : it - nQ) * 256 + tid, r = u >> 3, h = u & 7;
    float x[96];
    if (isq) {
      const uint4* src = (const uint4*)((const u16*)(p.ws + B_QB) + (size_t)r * 768 + h * 96);
      uint4 v[12];
#pragma unroll
      for (int i = 0; i < 12; ++i) v[i] = src[i];
#pragma unroll
      for (int i = 0; i < 12; ++i) unpack8(v[i], x + i * 8);
    } else {
      const uint4* s0 = (const uint4*)((const u16*)(p.ws + B_KVR) + (size_t)r * 1024 + h * 64);
      const uint4* s1 = (const uint4*)((const u16*)(p.ws + B_KRB) + (size_t)r * 32);
      uint4 v[12];
#pragma unroll
      for (int i = 0; i < 8; ++i) v[i] = s0[i];
#pragma unroll
      for (int i = 0; i < 4; ++i) v[8 + i] = s1[i];
#pragma unroll
      for (int i = 0; i < 12; ++i) unpack8(v[i], x + i * 8);
    }
    float ss = 0.f;
#pragma unroll
    for (int e = 0; e < 96; ++e) ss += x[e] * x[e];
    const float eps2 = isq ? EPS * (((const float*)(p.ws + B_RQ))[r] + EPS) : EPS;
    const float rstd = rsqrtf(ss * (1.f / 96.f) + eps2);
    const float* g = p.in[isq ? 22 : 23] + l * 96;
#pragma unroll
    for (int e = 0; e < 96; ++e) x[e] *= rstd * g[e];
    const bool rope = isq ? (r >= 1024) : (r >= 1280);
    if (rope) {
      const int s = r - (isq ? 1024 : 1280);
#pragma unroll
      for (int hh = 0; hh < 2; ++hh) {
        const int pos = hh ? (s & 63) : (s >> 6);
        const float* cs = TAB_CSM(p.ws) + pos * 16;
#pragma unroll
        for (int i = 0; i < 8; ++i) {
          const float a = x[64 + hh * 16 + i], b = x[64 + hh * 16 + 8 + i], c = cs[2 * i], sn = cs[2 * i + 1];
          x[64 + hh * 16 + i] = a * c - b * sn; x[64 + hh * 16 + 8 + i] = a * sn + b * c;
        }
      }
    }
    const float sc = isq ? QS_M : 1.f;
#pragma unroll
    for (int e = 0; e < 96; ++e) x[e] *= sc;
    uint4* dst = isq ? (uint4*)((u16*)(p.ws + B_QB) + (size_t)r * 768 + h * 96) : (uint4*)((u16*)(p.ws + B_KB) + (size_t)r * 768 + h * 96);
#pragma unroll
    for (int i = 0; i < 12; ++i) dst[i] = pack8(x + i * 8);
  }
}

template <int DQK, int DV, int NQT>
DI void attn_core(const u16* __restrict__ Q, int ldq, const u16* __restrict__ Kg, int ldk, const u16* __restrict__ Vg, int ldv, int ntiles, char* smem,
                  f32x4 (&o)[DV / 16][NQT], float (&lsum)[NQT]) {
  constexpr int CK = DQK / 8, CV = DV / 8, KBY = 64 * CK * 16, STAGE = KBY + 64 * CV * 16;
  constexpr int NKI = CK / 4, NVI = CV / 4;
  static_assert(2 * STAGE <= 65536 && NQT == 2, "cfg");
  const int tid = ltid(), lane = tid & 63, w = tid >> 6, g = lane >> 4, li = lane & 15;
  bf16x8 qf[NQT][DQK / 32];
#pragma unroll
  for (int nt = 0; nt < NQT; ++nt)
#pragma unroll
    for (int ks = 0; ks < DQK / 32; ++ks) qf[nt][ks] = *(const bf16x8*)(Q + (size_t)(w * 16 * NQT + nt * 16 + li) * ldq + ks * 32 + g * 8);
#pragma unroll
  for (int vt = 0; vt < DV / 16; ++vt)
#pragma unroll
    for (int nt = 0; nt < NQT; ++nt) o[vt][nt] = (f32x4){0.f, 0.f, 0.f, 0.f};
#pragma unroll
  for (int nt = 0; nt < NQT; ++nt) lsum[nt] = 0.f;
  f32x4 ol[NQT];
#pragma unroll
  for (int nt = 0; nt < NQT; ++nt) ol[nt] = (f32x4){0.f, 0.f, 0.f, 0.f};
  const bf16x8 ones = {(short)0x3F80, (short)0x3F80, (short)0x3F80, (short)0x3F80, (short)0x3F80, (short)0x3F80, (short)0x3F80, (short)0x3F80};
  int ko0 = 0, ko1 = 0, ko2 = 0, vo0 = 0, vo1 = 0, vo2 = 0, vo3 = 0;
#define KOFF(i_) ([&]() { const int n = (w + 4 * (i_)) * 64 + lane, row = n / CK, pos = n % CK; \
    const int c = (CK == 12) ? ((pos & ~3) | ((pos & 3) ^ ((row >> 2) & 3))) : (pos ^ ((row >> 1) & 7)); return row * ldk + c * 8; }())
#define VOFF(i_) ([&]() { const int n = (w + 4 * (i_)) * 64 + lane, row = n / CV, pos = n % CV; \
    const int c = (CV == 8) ? (pos ^ ((row >> 1) & 7)) : (pos ^ (row & 15)); return row * ldv + c * 8; }())
  ko0 = KOFF(0); ko1 = KOFF(1); if (NKI > 2) ko2 = KOFF(2);
  vo0 = VOFF(0); vo1 = VOFF(1); if (NVI > 2) { vo2 = VOFF(2); vo3 = VOFF(3); }
#undef KOFF
#undef VOFF
#define A_GLDS(t_, st_) do { const u16* kp_ = Kg + (size_t)(t_) * 64 * ldk; const u16* vp_ = Vg + (size_t)(t_) * 64 * ldv; char* sk_ = smem + (st_) * STAGE + w * 1024; \
    __builtin_amdgcn_global_load_lds((const unsigned*)(kp_ + ko0), (unsigned*)(sk_), 16, 0, 0); \
    __builtin_amdgcn_global_load_lds((const unsigned*)(kp_ + ko1), (unsigned*)(sk_ + 4096), 16, 0, 0); \
    if (NKI > 2) __builtin_amdgcn_global_load_lds((const unsigned*)(kp_ + ko2), (unsigned*)(sk_ + 8192), 16, 0, 0); \
    __builtin_amdgcn_global_load_lds((const unsigned*)(vp_ + vo0), (unsigned*)(sk_ + KBY), 16, 0, 0); \
    __builtin_amdgcn_global_load_lds((const unsigned*)(vp_ + vo1), (unsigned*)(sk_ + KBY + 4096), 16, 0, 0); \
    if (NVI > 2) { __builtin_amdgcn_global_load_lds((const unsigned*)(vp_ + vo2), (unsigned*)(sk_ + KBY + 8192), 16, 0, 0); \
                   __builtin_amdgcn_global_load_lds((const unsigned*)(vp_ + vo3), (unsigned*)(sk_ + KBY + 12288), 16, 0, 0); } } while (0)
  const unsigned sbase = (unsigned)(size_t)smem;
  unsigned kb0, kb1;
  if (CK == 12) { kb0 = (unsigned)(li * 192 + ((g ^ ((li >> 2) & 3)) << 4)); kb1 = kb0; }
  else { const int p0 = g ^ ((li >> 1) & 7); kb0 = (unsigned)(li * 128 + (p0 << 4)); kb1 = (unsigned)(li * 128 + ((p0 ^ 4) << 4)); }
  unsigned vb[DV / 16];
  { const int rowl = 4 * g + (li >> 2), b = (li & 3) >> 1, h8 = (li & 3) & 1;
    const int f = (CV == 8) ? ((2 * g + (li >> 3)) & 7) : ((4 * g + (li >> 2)) & 15);
#pragma unroll
    for (int vt = 0; vt < DV / 16; ++vt) vb[vt] = (unsigned)(KBY + rowl * CV * 16 + (((vt * 2 + b) ^ f) << 4) + h8 * 8); }
  RAW_BARRIER();
  A_GLDS(0, 0);
#pragma unroll 1
  for (int t = 0; t < ntiles; ++t) {
    asm volatile("s_waitcnt vmcnt(0)" ::: "memory");
    RAW_BARRIER();
    A_GLDS((t + 1 < ntiles ? t + 1 : t), (t + 1) & 1);
    const unsigned st = sbase + (unsigned)((t & 1) * STAGE);
    bf16x8 kf[DQK / 32][4];
    if constexpr (DQK == 96) {
      const unsigned a0 = st + kb0;
      asm volatile(
        "ds_read_b128 %0, %12 offset:0\n\t"
        "ds_read_b128 %1, %12 offset:3072\n\t"
        "ds_read_b128 %2, %12 offset:6144\n\t"
        "ds_read_b128 %3, %12 offset:9216\n\t"
        "ds_read_b128 %4, %12 offset:64\n\t"
        "ds_read_b128 %5, %12 offset:3136\n\t"
        "ds_read_b128 %6, %12 offset:6208\n\t"
        "ds_read_b128 %7, %12 offset:9280\n\t"
        "ds_read_b128 %8, %12 offset:128\n\t"
        "ds_read_b128 %9, %12 offset:3200\n\t"
        "ds_read_b128 %10, %12 offset:6272\n\t"
        "ds_read_b128 %11, %12 offset:9344\n\t"
        "s_waitcnt lgkmcnt(8)"
        : "=&v"(kf[0][0]), "=&v"(kf[0][1]), "=&v"(kf[0][2]), "=&v"(kf[0][3]), "=&v"(kf[1][0]), "=&v"(kf[1][1]), "=&v"(kf[1][2]), "=&v"(kf[1][3]), "=&v"(kf[2][0]), "=&v"(kf[2][1]), "=&v"(kf[2][2]), "=&v"(kf[2][3])
        : "v"(a0) : "memory");
    } else {
      const unsigned a0 = st + kb0, a1 = st + kb1;
      asm volatile(
        "ds_read_b128 %0, %8 offset:0\n\t"
        "ds_read_b128 %1, %8 offset:2048\n\t"
        "ds_read_b128 %2, %8 offset:4096\n\t"
        "ds_read_b128 %3, %8 offset:6144\n\t"
        "ds_read_b128 %4, %9 offset:0\n\t"
        "ds_read_b128 %5, %9 offset:2048\n\t"
        "ds_read_b128 %6, %9 offset:4096\n\t"
        "ds_read_b128 %7, %9 offset:6144\n\t"
        "s_waitcnt lgkmcnt(0)"
        : "=&v"(kf[0][0]), "=&v"(kf[0][1]), "=&v"(kf[0][2]), "=&v"(kf[0][3]), "=&v"(kf[1][0]), "=&v"(kf[1][1]), "=&v"(kf[1][2]), "=&v"(kf[1][3])
        : "v"(a0), "v"(a1) : "memory");
    }
    f32x4 s[4][NQT];
#pragma unroll
    for (int mt = 0; mt < 4; ++mt)
#pragma unroll
      for (int nt = 0; nt < NQT; ++nt) s[mt][nt] = (f32x4){0.f, 0.f, 0.f, 0.f};
#pragma unroll
    for (int ks = 0; ks < DQK / 32; ++ks) {
      if constexpr (DQK == 96) {
        if (ks == 1) asm volatile("s_waitcnt lgkmcnt(4)" : "+v"(kf[1][0]), "+v"(kf[1][1]), "+v"(kf[1][2]), "+v"(kf[1][3]), "+v"(s[2][NQT - 1]) :: "memory");
        if (ks == 2) asm volatile("s_waitcnt lgkmcnt(0)" : "+v"(kf[2][0]), "+v"(kf[2][1]), "+v"(kf[2][2]), "+v"(kf[2][3]), "+v"(s[2][NQT - 1]) :: "memory");
      }
#pragma unroll
      for (int mt = 0; mt < 4; ++mt)
#pragma unroll
        for (int nt = 0; nt < NQT; ++nt) s[mt][nt] = mfma16(kf[ks][mt], qf[nt][ks], s[mt][nt]);
    }
    s16x4 va[DV / 16][2], vc[DV / 16][2];
    unsigned va_[DV / 16];
#pragma unroll
    for (int vt = 0; vt < DV / 16; ++vt) va_[vt] = st + vb[vt];
    if constexpr (DV == 64) {
      asm volatile(
        "ds_read_b64_tr_b16 %0, %8 offset:0\n\t"
        "ds_read_b64_tr_b16 %1, %8 offset:2048\n\t"
        "ds_read_b64_tr_b16 %2, %9 offset:0\n\t"
        "ds_read_b64_tr_b16 %3, %9 offset:2048\n\t"
        "ds_read_b64_tr_b16 %4, %10 offset:0\n\t"
        "ds_read_b64_tr_b16 %5, %10 offset:2048\n\t"
        "ds_read_b64_tr_b16 %6, %11 offset:0\n\t"
        "ds_read_b64_tr_b16 %7, %11 offset:2048"
        : "=&v"(va[0][0]), "=&v"(va[0][1]), "=&v"(va[1][0]), "=&v"(va[1][1]), "=&v"(va[2][0]), "=&v"(va[2][1]), "=&v"(va[3][0]), "=&v"(va[3][1])
        : "v"(va_[0]), "v"(va_[1]), "v"(va_[2]), "v"(va_[3]) : "memory");
    } else {
      asm volatile(
        "ds_read_b64_tr_b16 %0, %16 offset:0\n\t"
        "ds_read_b64_tr_b16 %1, %16 offset:4096\n\t"
        "ds_read_b64_tr_b16 %2, %17 offset:0\n\t"
        "ds_read_b64_tr_b16 %3, %17 offset:4096\n\t"
        "ds_read_b64_tr_b16 %4, %18 offset:0\n\t"
        "ds_read_b64_tr_b16 %5, %18 offset:4096\n\t"
        "ds_read_b64_tr_b16 %6, %19 offset:0\n\t"
        "ds_read_b64_tr_b16 %7, %19 offset:4096\n\t"
        "ds_read_b64_tr_b16 %8, %20 offset:0\n\t"
        "ds_read_b64_tr_b16 %9, %20 offset:4096\n\t"
        "ds_read_b64_tr_b16 %10, %21 offset:0\n\t"
        "ds_read_b64_tr_b16 %11, %21 offset:4096\n\t"
        "ds_read_b64_tr_b16 %12, %22 offset:0\n\t"
        "ds_read_b64_tr_b16 %13, %22 offset:4096\n\t"
        "ds_read_b64_tr_b16 %14, %23 offset:0\n\t"
        "ds_read_b64_tr_b16 %15, %23 offset:4096"
        : "=&v"(va[0][0]), "=&v"(va[0][1]), "=&v"(va[1][0]), "=&v"(va[1][1]), "=&v"(va[2][0]), "=&v"(va[2][1]), "=&v"(va[3][0]), "=&v"(va[3][1]), "=&v"(va[4][0]), "=&v"(va[4][1]), "=&v"(va[5][0]), "=&v"(va[5][1]), "=&v"(va[6][0]), "=&v"(va[6][1]), "=&v"(va[7][0]), "=&v"(va[7][1])
        : "v"(va_[0]), "v"(va_[1]), "v"(va_[2]), "v"(va_[3]), "v"(va_[4]), "v"(va_[5]), "v"(va_[6]), "v"(va_[7]) : "memory");
    }
#pragma unroll
    for (int mt = 0; mt < 4; ++mt)
#pragma unroll
      for (int nt = 0; nt < NQT; ++nt)
#pragma unroll
        for (int jj = 0; jj < 4; ++jj) { const float e = __builtin_amdgcn_exp2f(s[mt][nt][jj]); s[mt][nt][jj] = e; if constexpr (DV != 64) lsum[nt] += e; }
    bf16x8 pf0[NQT], pf1[NQT];
#pragma unroll
    for (int nt = 0; nt < NQT; ++nt) {
      uint4 u; u.x = pack2(s[0][nt][0], s[0][nt][1]); u.y = pack2(s[0][nt][2], s[0][nt][3]); u.z = pack2(s[1][nt][0], s[1][nt][1]); u.w = pack2(s[1][nt][2], s[1][nt][3]);
      pf0[nt] = __builtin_bit_cast(bf16x8, u);
      uint4 v; v.x = pack2(s[2][nt][0], s[2][nt][1]); v.y = pack2(s[2][nt][2], s[2][nt][3]); v.z = pack2(s[3][nt][0], s[3][nt][1]); v.w = pack2(s[3][nt][2], s[3][nt][3]);
      pf1[nt] = __builtin_bit_cast(bf16x8, v);
    }
    if constexpr (DV == 64) {
      asm volatile("s_waitcnt lgkmcnt(0)" : "+v"(va[0][0]), "+v"(va[0][1]), "+v"(va[1][0]), "+v"(va[1][1]), "+v"(va[2][0]), "+v"(va[2][1]), "+v"(va[3][0]), "+v"(va[3][1]) :: "memory");
      asm volatile(
        "ds_read_b64_tr_b16 %0, %8 offset:4096\n\t"
        "ds_read_b64_tr_b16 %1, %8 offset:6144\n\t"
        "ds_read_b64_tr_b16 %2, %9 offset:4096\n\t"
        "ds_read_b64_tr_b16 %3, %9 offset:6144\n\t"
        "ds_read_b64_tr_b16 %4, %10 offset:4096\n\t"
        "ds_read_b64_tr_b16 %5, %10 offset:6144\n\t"
        "ds_read_b64_tr_b16 %6, %11 offset:4096\n\t"
        "ds_read_b64_tr_b16 %7, %11 offset:6144"
        : "=&v"(vc[0][0]), "=&v"(vc[0][1]), "=&v"(vc[1][0]), "=&v"(vc[1][1]), "=&v"(vc[2][0]), "=&v"(vc[2][1]), "=&v"(vc[3][0]), "=&v"(vc[3][1])
        : "v"(va_[0]), "v"(va_[1]), "v"(va_[2]), "v"(va_[3]) : "memory");
    } else {
      asm volatile("s_waitcnt lgkmcnt(0)" : "+v"(va[0][0]), "+v"(va[0][1]), "+v"(va[1][0]), "+v"(va[1][1]), "+v"(va[2][0]), "+v"(va[2][1]), "+v"(va[3][0]), "+v"(va[3][1]), "+v"(va[4][0]), "+v"(va[4][1]), "+v"(va[5][0]), "+v"(va[5][1]), "+v"(va[6][0]), "+v"(va[6][1]), "+v"(va[7][0]), "+v"(va[7][1]) :: "memory");
    }
#pragma unroll
    for (int vt = 0; vt < DV / 16; ++vt) {
      const bf16x8 vf = __builtin_shufflevector(va[vt][0], va[vt][1], 0, 1, 2, 3, 4, 5, 6, 7);
#pragma unroll
      for (int nt = 0; nt < NQT; ++nt) o[vt][nt] = mfma16(vf, pf0[nt], o[vt][nt]);
    }
    if constexpr (DV == 64) {
#pragma unroll
      for (int nt = 0; nt < NQT; ++nt) ol[nt] = mfma16(ones, pf0[nt], ol[nt]);
    }
    if constexpr (DV == 64) { asm volatile("s_waitcnt lgkmcnt(0)" : "+v"(vc[0][0]), "+v"(vc[0][1]), "+v"(vc[1][0]), "+v"(vc[1][1]), "+v"(vc[2][0]), "+v"(vc[2][1]), "+v"(vc[3][0]), "+v"(vc[3][1]), "+v"(o[0][0]) :: "memory"); }
    else {
      asm volatile(
        "ds_read_b64_tr_b16 %0, %16 offset:8192\n\t"
        "ds_read_b64_tr_b16 %1, %16 offset:12288\n\t"
        "ds_read_b64_tr_b16 %2, %17 offset:8192\n\t"
        "ds_read_b64_tr_b16 %3, %17 offset:12288\n\t"
        "ds_read_b64_tr_b16 %4, %18 offset:8192\n\t"
        "ds_read_b64_tr_b16 %5, %18 offset:12288\n\t"
        "ds_read_b64_tr_b16 %6, %19 offset:8192\n\t"
        "ds_read_b64_tr_b16 %7, %19 offset:12288\n\t"
        "ds_read_b64_tr_b16 %8, %20 offset:8192\n\t"
        "ds_read_b64_tr_b16 %9, %20 offset:12288\n\t"
        "ds_read_b64_tr_b16 %10, %21 offset:8192\n\t"
        "ds_read_b64_tr_b16 %11, %21 offset:12288\n\t"
        "ds_read_b64_tr_b16 %12, %22 offset:8192\n\t"
        "ds_read_b64_tr_b16 %13, %22 offset:12288\n\t"
        "ds_read_b64_tr_b16 %14, %23 offset:8192\n\t"
        "ds_read_b64_tr_b16 %15, %23 offset:12288\n\t"
        "s_waitcnt lgkmcnt(0)"
        : "=&v"(vc[0][0]), "=&v"(vc[0][1]), "=&v"(vc[1][0]), "=&v"(vc[1][1]), "=&v"(vc[2][0]), "=&v"(vc[2][1]), "=&v"(vc[3][0]), "=&v"(vc[3][1]), "=&v"(vc[4][0]), "=&v"(vc[4][1]), "=&v"(vc[5][0]), "=&v"(vc[5][1]), "=&v"(vc[6][0]), "=&v"(vc[6][1]), "=&v"(vc[7][0]), "=&v"(vc[7][1])
        : "v"(va_[0]), "v"(va_[1]), "v"(va_[2]), "v"(va_[3]), "v"(va_[4]), "v"(va_[5]), "v"(va_[6]), "v"(va_[7]), "v"(o[DV / 16 - 1][NQT - 1]) : "memory");
    }
#pragma unroll
    for (int vt = 0; vt < DV / 16; ++vt) {
      const bf16x8 vf = __builtin_shufflevector(vc[vt][0], vc[vt][1], 0, 1, 2, 3, 4, 5, 6, 7);
#pragma unroll
      for (int nt = 0; nt < NQT; ++nt) o[vt][nt] = mfma16(vf, pf1[nt], o[vt][nt]);
    }
    if constexpr (DV == 64) {
#pragma unroll
      for (int nt = 0; nt < NQT; ++nt) ol[nt] = mfma16(ones, pf1[nt], ol[nt]);
    }
  }
  asm volatile("s_waitcnt vmcnt(0)" ::: "memory");
  RAW_BARRIER();
#undef A_GLDS
#pragma unroll
  for (int nt = 0; nt < NQT; ++nt) { if constexpr (DV == 64) lsum[nt] = ol[nt][0]; else { float v = lsum[nt]; v += __shfl_xor(v, 16); v += __shfl_xor(v, 32); lsum[nt] = v; } }
}

#ifndef NQTM
#define NQTM 2
#endif
#ifndef NQTD
#define NQTD 2
#endif
constexpr int NQT_M = NQTM, NQT_D = NQTD;
DI void mla_item(const Params& p, int sq, int h, int qb, char* smem) {
  constexpr int QR = 64 * NQT_M;
  const int lane = ltid() & 63, w = ltid() >> 6;
  const int row0 = (sq < 4 ? sq * 256 : 1024) + qb * QR;
  const int key0 = sq < 4 ? sq * 256 : 1024;
  const int ntiles = sq < 4 ? 4 : 68;
  f32x4 o[4][NQT_M]; float ls[NQT_M];
  attn_core<96, 64, NQT_M>((const u16*)(p.ws + B_QB) + (size_t)row0 * 768 + h * 96, 768, (const u16*)(p.ws + B_KB) + (size_t)key0 * 768 + h * 96, 768,
                           (const u16*)(p.ws + B_KVR) + (size_t)key0 * 1024 + 512 + h * 64, 1024, ntiles, smem, o, ls);
  u16* Y = (u16*)(p.ws + B_Y);
#pragma unroll
  for (int nt = 0; nt < NQT_M; ++nt) {
    const float inv = 1.f / ls[nt];
    const int row = row0 + w * 16 * NQT_M + nt * 16 + (lane & 15);
#pragma unroll
    for (int vt = 0; vt < 4; ++vt) {
      uint2 u; u.x = pack2(o[vt][nt][0] * inv, o[vt][nt][1] * inv); u.y = pack2(o[vt][nt][2] * inv, o[vt][nt][3] * inv);
      *(uint2*)(Y + (size_t)row * 1536 + 512 + h * 64 + vt * 16 + (lane >> 4) * 4) = u;
    }
  }
}
DI void diff_item(const Params& p, int sq, int h, int comp, int qb, char* smem) {
  constexpr int QR = 64 * NQT_D;
  const int lane = ltid() & 63, w = ltid() >> 6;
  const int row0 = (sq < 4 ? sq * 256 : 1024) + qb * QR;
  const int key0 = sq < 4 ? sq * 256 : 1024;
  const int ntiles = sq < 4 ? 4 : 68;
  const u16* QC = (const u16*)(p.ws + B_QC); const u16* KC = (const u16*)(p.ws + B_KC); const u16* VC = (const u16*)(p.ws + B_VC);
  f32x4 o[8][NQT_D]; float ls[NQT_D];
  attn_core<64, 128, NQT_D>(QC + (size_t)row0 * 512 + (h * 2 + comp) * 64, 512, KC + (size_t)key0 * 512 + (h * 2 + comp) * 64, 512, VC + (size_t)key0 * 512 + h * 128, 512, ntiles, smem, o, ls);
  u16* T = (u16*)(p.ws + B_T);
#pragma unroll
  for (int nt = 0; nt < NQT_D; ++nt) {
    const float inv = 1.f / ls[nt];
    const int row = row0 + w * 16 * NQT_D + nt * 16 + (lane & 15);
#pragma unroll
    for (int vt = 0; vt < 8; ++vt) {
      uint2 u; u.x = pack2(o[vt][nt][0] * inv, o[vt][nt][1] * inv); u.y = pack2(o[vt][nt][2] * inv, o[vt][nt][3] * inv);
      *(uint2*)(T + ((size_t)row * 2 + comp) * 512 + h * 128 + vt * 16 + (lane >> 4) * 4) = u;
    }
  }
}
DI void phaseF2(const Params& p, int l, int j) {
  const int tid = ltid();
  const float lam = TAB_LAM(p.ws)[l];
  const float post = 1.f - (l == 0 ? 0.2f : 0.35550906759096926f);
  const float* gs = p.in[27] + l * 128;
  for (int it = blockIdx.x; it < TJ * 16 / 256; it += gridDim.x) {
    const int u = it * 256 + tid, r = u >> 4, h = (u >> 2) & 3, qd = u & 3;
    const uint4* s1 = (const uint4*)((const u16*)(p.ws + B_T) + ((size_t)r * 2) * 512 + h * 128 + qd * 32);
    const uint4* s2 = (const uint4*)((const u16*)(p.ws + B_T) + ((size_t)r * 2 + 1) * 512 + h * 128 + qd * 32);
    float x[32]; float ss = 0.f;
#pragma unroll
    for (int i = 0; i < 4; ++i) {
      const uint4 a = s1[i], b = s2[i];
      float xa[8], xb[8]; unpack8(a, xa); unpack8(b, xb);
#pragma unroll
      for (int e = 0; e < 8; ++e) { const float v = xa[e] - lam * xb[e]; x[i * 8 + e] = v; ss += v * v; }
    }
    ss += __shfl_xor(ss, 1); ss += __shfl_xor(ss, 2);
    const float rstd = rsqrtf(ss * (1.f / 128.f) + EPS) * post;
    uint4* dst = (uint4*)((u16*)(p.ws + B_Y) + (size_t)r * 1536 + 1024 + h * 128 + qd * 32);
#pragma unroll
    for (int i = 0; i < 4; ++i) {
      float y[8];
#pragma unroll
      for (int e = 0; e < 8; ++e) y[e] = x[i * 8 + e] * rstd * gs[qd * 32 + i * 8 + e];
      dst[i] = pack8(y);
    }
  }
}
#ifndef FMASK
#define FMASK 31
#endif
DI void phaseF(const Params& p, int l, int j, char* smem, int kmask = 7) {
  constexpr int QBM = 4096 / (64 * NQT_M), QBD = 4096 / (64 * NQT_D), CBM = 256 / (64 * NQT_M), CBD = 256 / (64 * NQT_D);
  const int nDL = 8 * QBD, nML = 8 * QBM, nG3 = 0, nMC = 4 * 8 * CBM, nDC = 4 * 8 * CBD;
  for (int it = blockIdx.x; it < nDL + nML + nG3 + nMC + nDC; it += gridDim.x) {
    int q = it, kind, sq = 4, h = 0, qb = 0;
    if (q < nDL) { kind = 0; h = q % 8; qb = q / 8; }
    else if ((q -= nDL) < nML) { kind = 1; h = q % 8; qb = q / 8; }
    else if ((q -= nML) < nG3) { kind = 2; }
    else if ((q -= nG3) < nMC) { kind = 1; sq = q / (8 * CBM); h = (q / CBM) % 8; qb = q % CBM; }
    else { q -= nMC; kind = 0; sq = q / (8 * CBD); h = (q / CBD) % 8; qb = q % CBD; }
    if (!((kmask >> kind) & 1)) continue;
    if (kind == 0) diff_item(p, sq, h >> 1, h & 1, qb, smem);
    else if (kind == 1) mla_item(p, sq, h, qb, smem);
    else gla_g3_item(p, l, q >> 2, q & 3, smem);
  }
}

DI void phaseG(const Params& p, int l, int j, char* smem) {
  const u16* Y = (const u16*)(p.ws + B_Y); const u16* P = (const u16*)(p.ws + B_P); u16* Mg = (u16*)(p.ws + B_H);
  for (int it = blockIdx.x; it < 64 * 8; it += gridDim.x) {
    const int mt = it % 64, nt = it / 64;
    const int lane = ltid() & 63, wid = ltid() >> 6;
    const int col = nt * 128 + wid * 32 + (lane >> 4) * 8;
    f32x4 tot[5][2]; zero_acc80(tot);
    for (int br = 0; br < 3; ++br) {
      f32x4 acc[5][2]; zero_acc80(acc);
      gemm80_glds(Y + (size_t)mt * 80 * 1536 + br * 512, 1536, (const u16*)(p.ws + W_O) + (size_t)(l * 3 + br) * 1024 * 512 + (size_t)nt * 128 * 512, 512, 512, smem, acc);
#pragma unroll
      for (int mi = 0; mi < 5; ++mi) {
        const int row = mt * 80 + mi * 16 + (lane & 15);
        const uint4 gv = *(const uint4*)(P + (size_t)row * INP + cGT + br * 1024 + col);
        float g[8]; unpack8(gv, g);
#pragma unroll
        for (int e = 0; e < 4; ++e) { tot[mi][0][e] += sigmoidf_(g[e]) * acc[mi][0][e]; tot[mi][1][e] += sigmoidf_(g[4 + e]) * acc[mi][1][e]; }
      }
    }
#pragma unroll
    for (int mi = 0; mi < 5; ++mi) {
      const int row = mt * 80 + mi * 16 + (lane & 15);
      uint4 o; o.x = pack2(tot[mi][0][0], tot[mi][0][1]); o.y = pack2(tot[mi][0][2], tot[mi][0][3]); o.z = pack2(tot[mi][1][0], tot[mi][1][1]); o.w = pack2(tot[mi][1][2], tot[mi][1][3]);
      *(uint4*)(Mg + (size_t)row * 1024 + col) = o;
    }
  }
}
DI void phase_resid(const Params& p, int l, int j, int which, char* smem, bool dry = false) {
  const u16* A = which ? (const u16*)(p.ws + B_P) : (const u16*)(p.ws + B_H);
  const int K = which ? 4096 : 1024;
  const u16* W = which ? (const u16*)(p.ws + W_2) + (size_t)l * 1024 * 4096 : (const u16*)(p.ws + W_OUT) + (size_t)l * 1024 * 1024;
  for (int it = blockIdx.x; it < 64 * 8; it += gridDim.x) {
    const int mt = it % 64, nt = it / 64;
    f32x4 acc[5][2]; zero_acc80(acc);
    gemm80_glds(A + (size_t)mt * 80 * K, K, W + (size_t)nt * 128 * K, K, K, smem, acc);
    epi80_foreach(acc, [&](int row, int col, f32x4 v) {
      const Tok t = tokinfo(j, mt * 80 + row);
      const int c = nt * 128 + col;
      const float* xs = (l == 0 && which == 0) ? (t.g < 4096 ? p.in[0] + (size_t)t.g * 1024 : p.in[1] + (size_t)(t.g - 4096) * 1024) : p.out + (size_t)t.g * 1024;
      const float4 x4 = *(const float4*)(xs + c);
      const float4 g4 = *(const float4*)((const float*)(p.ws + B_MOD) + (l * 5 + t.cond) * 6144 + (which ? 5 : 2) * 1024 + c);
      float4 y; y.x = x4.x + g4.x * v[0]; y.y = x4.y + g4.y * v[1]; y.z = x4.z + g4.z * v[2]; y.w = x4.w + g4.w * v[3];
      if (!dry || v[0] == 12345.678f) *(float4*)(p.out + (size_t)t.g * 1024 + c) = y;
    });
  }
}
DI void phaseB(const Params& p, int l, int j, char* smem) {
  for (int it = blockIdx.x; it < 40 * NT_B; it += gridDim.x) inproj_tile(p, l, it % 40, it / 40, smem);
}
DI void phaseJ(const Params& p, int l, int j, char* smem) {
  u16* Hd = (u16*)(p.ws + B_P);
  for (int it = blockIdx.x; it < 40 * 32; it += gridDim.x) {
    const int mt = it % 40, nt = it / 40;
    f32x4 acc[4][4]; zero_acc(acc);
    gemm_accum_glds((const u16*)(p.ws + B_H) + (size_t)mt * 128 * 1024, 1024, (const u16*)(p.ws + W_1) + (size_t)l * 4096 * 1024 + (size_t)nt * 128 * 1024, 1024, 1024, smem, acc);
    epi_foreach8(acc, [&](int row, int col, f32x4 v, f32x4 w) {
      const float r0 = fmaxf(v[0], 0.f), r1 = fmaxf(v[1], 0.f), r2 = fmaxf(v[2], 0.f), r3 = fmaxf(v[3], 0.f);
      const float r4 = fmaxf(w[0], 0.f), r5 = fmaxf(w[1], 0.f), r6 = fmaxf(w[2], 0.f), r7 = fmaxf(w[3], 0.f);
      uint4 o; o.x = pack2(r0 * r0, r1 * r1); o.y = pack2(r2 * r2, r3 * r3); o.z = pack2(r4 * r4, r5 * r5); o.w = pack2(r6 * r6, r7 * r7);
      *(uint4*)(Hd + (size_t)(mt * 128 + row) * 4096 + nt * 128 + col) = o; });
  }
  if (l == 0 && defer_l1()) {
    const int per = (XT_PER_LAYER + NJ - 1) / NJ, lo = j * per, hi = (lo + per < XT_PER_LAYER) ? lo + per : XT_PER_LAYER;
    if ((int)blockIdx.x >= 256)
      for (int q = lo + ((int)blockIdx.x - 256); q < hi; q += (int)gridDim.x - 256) xpose_item(p, 1, q, smem);
  }
}

#ifndef PHMASK0
#define PHMASK0 1
#endif
DI void run_phase(const Params& p, int id, char* smem) {
  if (id == 0) { if (PHMASK0) phase0(p, smem); return; }
  int nl = -1, nj = 0, nw = 0, rw = -1, l = 0, j = 0;
  if (id == 1) { nl = 0; }
  else {
    const int q = id - 2, ph = q % NPH, lj = q / NPH;
    j = lj % NJ; l = lj / NJ;
    switch (ph) {
      case 0: phaseB(p, l, j, smem); break;
      case 1: phaseC(p, l, j, smem); break;
      case 2: phaseD(p, l, j, smem); break;
      case 3: phaseE(p, l, j, smem); break;
      case 4: phaseF(p, l, j, smem); break;
      case 5: phaseF2(p, l, j); break;
      case 6: phaseG(p, l, j, smem); break;
      case 7: rw = 0; break;
      case 8: nl = l; nj = j; nw = 1; break;
      case 9: phaseJ(p, l, j, smem); break;
      default:
        rw = 1;
        if (lj + 1 < DEPTH * NJ) { nl = (lj + 1) / NJ; nj = (lj + 1) % NJ; nw = 0; }
        break;
    }
  }
  if (rw >= 0) phase_resid(p, l, j, rw, smem);
  if (nl >= 0) ph_normmod(p, nl, nj, nw);
}
constexpr int N_PHASES = 2 + DEPTH * NJ * NPH;

#define XB_TMO      128
#define XB_XCNT(j)  (256  + 64 * (j))
#define XB_XSUB(j)  (1280 + 64 * (j))
#define XB_XGEN(j)  (2304 + 64 * (j))
#define XB_TOP      3328
#define XB_TOPGEN   3392
#define XCD_BAR_WORDS 3456
#define XB_SPIN_CAP (1u << 20)
DI unsigned xb_ld(unsigned* p) { return __hip_atomic_load(p, __ATOMIC_RELAXED, __HIP_MEMORY_SCOPE_AGENT); }
DI unsigned xb_add(unsigned* p, unsigned v) { return __hip_atomic_fetch_add(p, v, __ATOMIC_RELAXED, __HIP_MEMORY_SCOPE_AGENT); }
DI unsigned xb_xcc_id() { return (unsigned)__builtin_amdgcn_s_getreg((3 << 11) | 20) & 0xFu; }
#define XB_SPIN(cond, bar) do { unsigned _sp = 0; while (cond) { __builtin_amdgcn_s_sleep(1); \
    if ((++_sp & 255u) == 0u) { if (xb_ld(&(bar)[XB_TMO])) break; if (_sp > XB_SPIN_CAP) { atomicAdd(&(bar)[XB_TMO], 1u); break; } } } } while (0)
DI void xcd_barrier_complete(unsigned* bar, unsigned x, unsigned& nloc, unsigned& nx) {
  const unsigned G = gridDim.x;
  unsigned sum, cnt, mine, sp = 0u;
  for (;;) {
    sum = 0u; cnt = 0u; mine = 0u;
#pragma unroll
    for (unsigned j = 0; j < 16; ++j) { const unsigned c = xb_ld(&bar[XB_XCNT(j)]); sum += c; cnt += (c > 0u) ? 1u : 0u; mine = (j == x) ? c : mine; }
    if (sum == G) break;
    __builtin_amdgcn_s_sleep(1);
    if ((++sp & 255u) == 0u) { if (xb_ld(&bar[XB_TMO])) break; if (sp > XB_SPIN_CAP) { atomicAdd(&bar[XB_TMO], 1u); break; } }
  }
  nloc = mine > 0u ? mine : 1u; nx = cnt > 0u ? cnt : 1u;
}
DI void xcd_barrier(unsigned* bar, unsigned x, volatile unsigned* st) {
  asm volatile("s_waitcnt vmcnt(0)" ::: "memory");
  __syncthreads();
  if (ltid() == 0) {
    __builtin_amdgcn_s_waitcnt(0);
    unsigned nloc = st[0], nx = st[1];
    if (nloc == 0u) { xcd_barrier_complete(bar, x, nloc, nx); st[0] = nloc; st[1] = nx; }
    const unsigned old = xb_add(&bar[XB_XSUB(x)], 1u);
    const unsigned gen = old / nloc;
    if (old + 1u == (gen + 1u) * nloc) {
      __builtin_amdgcn_fence(__ATOMIC_RELEASE, "agent");
      asm volatile("s_waitcnt vmcnt(0)" ::: "memory");
      const unsigned og = xb_add(&bar[XB_TOP], 1u);
      const unsigned tg = og / nx;
      if (og + 1u == (tg + 1u) * nx) xb_add(&bar[XB_TOPGEN], 1u);
      else XB_SPIN(xb_ld(&bar[XB_TOPGEN]) == tg, bar);
      __builtin_amdgcn_fence(__ATOMIC_ACQUIRE, "agent");
      xb_add(&bar[XB_XGEN(x)], 1u);
      asm volatile("s_waitcnt vmcnt(0)" ::: "memory");
    } else {
      XB_SPIN(xb_ld(&bar[XB_XGEN(x)]) == gen, bar);
      __builtin_amdgcn_fence(__ATOMIC_ACQUIRE, "agent");
      asm volatile("s_waitcnt vmcnt(0)" ::: "memory");
    }
  }
  __syncthreads();
}

__global__ void __launch_bounds__(256, 2) mega(Params p, int ph_lo, int ph_hi) {
  __shared__ __attribute__((aligned(16))) char smem[65536];
#if !MULTI_LAUNCH
  cg::grid_group grid = cg::this_grid();
  __shared__ uint4 xb_words;
  unsigned* bar = (unsigned*)(p.ws + WS_END);
  const unsigned xcc = xb_xcc_id();
  if (ltid() == 0) { xb_words = make_uint4(0u, 0u, 0u, 0u); (void)xb_add(&bar[XB_XCNT(xcc)], 1u); }
  __syncthreads();
#endif
  for (int id = ph_lo; id < ph_hi; ++id) {
    run_phase(p, id, smem);
#if !MULTI_LAUNCH
    if (id + 1 < ph_hi) {
      if (id == ph_lo) grid.sync();
      else {
        xcd_barrier(bar, xcc, (volatile unsigned*)&xb_words);
#ifdef DUPBAR
        xcd_barrier(bar, xcc, (volatile unsigned*)&xb_words);
#endif
      }
    }
#endif
  }
}

extern "C" void kernel_launch(void* const* d_in, const int* in_sizes, int n_in, void* d_out, int out_size, void* d_ws, size_t ws_size, hipStream_t stream) {
  static int grid_blocks = 0;
  if (!grid_blocks) {
    int dev = 0, cus = 0, per_cu = 0;
    hipGetDevice(&dev);
    hipDeviceGetAttribute(&cus, hipDeviceAttributeMultiprocessorCount, dev);
    hipOccupancyMaxActiveBlocksPerMultiprocessor(&per_cu, mega, 256, 0);
    if (per_cu < 1) per_cu = 1;
    if (per_cu > 2) per_cu = 2;
    grid_blocks = cus * per_cu;
    if (ws_size < WS_END + XCD_BAR_WORDS * 4) fprintf(stderr, "kernel_launch: workspace too small: %zu < %zu\n", ws_size, (size_t)WS_END);
  }
  Params p{};
  for (int i = 0; i < 34; ++i) p.in[i] = (const float*)d_in[i];
  p.out = (float*)d_out; p.ws = (char*)d_ws;
  (void)hipMemsetAsync((char*)d_ws + WS_END, 0, XCD_BAR_WORDS * 4, stream);
#if MULTI_LAUNCH
  for (int id = 0; id < N_PHASES; ++id) hipLaunchKernelGGL(mega, dim3(grid_blocks), dim3(256), 0, stream, p, id, id + 1);
#else
  int lo = 0, hi = N_PHASES;
  void* args[] = {&p, &lo, &hi};
  hipError_t e = hipLaunchCooperativeKernel((void*)mega, dim3(grid_blocks), dim3(256), args, 0, stream);
  if (e != hipSuccess) fprintf(stderr, "cooperative launch failed: %s (grid %d)\n", hipGetErrorString(e), grid_blocks);
#endif
}
```
